# Optimizing an MI355X kernel written in HIP

```python
import math
import functools
import jax
import jax.numpy as jnp
from jax import lax
import numpy as np

D_MODEL = 2048
BATCH = 4
SEQ = 2048
DEPTH = 2

GRID_W = 64
CTX_LEN = 256
EPS = 1e-6
CHUNK = 64
HEAD_DIM = 128

S5_WIDTH = D_MODEL // 4
S5_GROUP = 16
S5_GROUPS = S5_WIDTH // S5_GROUP
S5_STATE = 64

GDN_WIDTH = 3 * D_MODEL // 8
GDN_HEADS = GDN_WIDTH // HEAD_DIM
GDN_DK = HEAD_DIM
GDN_DV = HEAD_DIM
GDN_CONV = 3

MLSTM_WIDTH = D_MODEL - S5_WIDTH - GDN_WIDTH
MLSTM_HEADS = MLSTM_WIDTH // HEAD_DIM
MLSTM_DK = HEAD_DIM // 2
MLSTM_DV = HEAD_DIM

FFN_HIDDEN = -(-8 * D_MODEL // (3 * 256)) * 256

IN_SIZES = (S5_WIDTH,
            GDN_HEADS * GDN_DK, GDN_HEADS * GDN_DK, GDN_HEADS * GDN_DV, GDN_HEADS * GDN_DV,
            2 * GDN_HEADS, 2 * GDN_HEADS,
            MLSTM_HEADS * MLSTM_DK, MLSTM_HEADS * MLSTM_DK, MLSTM_HEADS * MLSTM_DV, MLSTM_HEADS * MLSTM_DV,
            2 * MLSTM_HEADS, 2 * MLSTM_HEADS)
IN_COLS = sum(IN_SIZES)

kernel_name = 'hybrid_s5_gdn_mlstm_prefix_backbone'

F32 = jnp.float32


def rms_norm(x, g):
    xf = x.astype(F32)
    y = xf * lax.rsqrt(jnp.mean(xf * xf, axis=-1, keepdims=True) + EPS)
    return (y * g.astype(F32)).astype(x.dtype)


def l2norm(x):
    return x * lax.rsqrt(jnp.sum(x * x, axis=-1, keepdims=True) + EPS)


def modulate(x, g, shift, scale):
    return rms_norm(x, g) * (1 + scale) + shift


def swiglu(h, w_gate, w_up, w_down):
    return (jax.nn.silu(h @ w_gate) * (h @ w_up)) @ w_down


def split_cols(p):
    idx, off = [], 0
    for s in IN_SIZES[:-1]:
        off += s
        idx.append(off)
    return jnp.split(p, idx, axis=-1)


def short_conv(x, w):
    x = x.astype(F32)
    w = w.astype(F32)
    k = w.shape[0]
    pad = k // 2
    t = x.shape[1]
    xp = jnp.pad(x, ((0, 0), (pad, pad), (0, 0)))
    y = xp[:, 0:t] * w[0]
    for j in range(1, k):
        y = y + xp[:, j:j + t] * w[j]
    return jax.nn.silu(y)


def to_col_major(a, rows):
    b = a.shape[0]
    a = a.reshape(b, rows, GRID_W, *a.shape[2:])
    a = jnp.swapaxes(a, 1, 2)
    return a.reshape(b, rows * GRID_W, *a.shape[3:])


def from_col_major(a, rows):
    b = a.shape[0]
    a = a.reshape(b, GRID_W, rows, *a.shape[2:])
    a = jnp.swapaxes(a, 1, 2)
    return a.reshape(b, rows * GRID_W, *a.shape[3:])


def to_chunks(a):
    b, t, h = a.shape[:3]
    a = a.reshape(b, t // CHUNK, CHUNK, h, *a.shape[3:])
    return jnp.moveaxis(a, 3, 1)


def from_chunks(a):
    b, h, n, c = a.shape[:4]
    return jnp.moveaxis(a, 1, 3).reshape(b, n * c, h, *a.shape[4:])


def flip_time(tup):
    return tuple(jnp.flip(a, axis=1) for a in tup)


def bidirectional(run_f, run_b, ctx_f, lat_f, ctx_b, lat_b, state0):
    y_ctx_f, st_f = run_f(ctx_f, state0)
    y_lat_f, _ = run_f(lat_f, st_f)
    y_ctx_b, st_b = run_b(flip_time(ctx_b), state0)
    y_lat_b, _ = run_b(flip_time(lat_b), st_b)
    return y_ctx_f + jnp.flip(y_ctx_b, axis=1), y_lat_f + jnp.flip(y_lat_b, axis=1)


def s5_discretise(lam_re, lam_im, log_dt, b_re, b_im):
    dt = jnp.exp(log_dt)[:, None]
    mag = jnp.exp(lam_re * dt)
    ab_re = mag * jnp.cos(lam_im * dt)
    ab_im = mag * jnp.sin(lam_im * dt)
    den = lam_re * lam_re + lam_im * lam_im
    f_re = ((ab_re - 1.0) * lam_re + ab_im * lam_im) / den
    f_im = (ab_im * lam_re - (ab_re - 1.0) * lam_im) / den
    bb_re = f_re[..., None] * b_re - f_im[..., None] * b_im
    bb_im = f_re[..., None] * b_im + f_im[..., None] * b_re
    return ab_re, ab_im, bb_re, bb_im


def complex_affine_combine(e1, e2):
    a1r, a1i, b1r, b1i = e1
    a2r, a2i, b2r, b2i = e2
    return (a2r * a1r - a2i * a1i, a2r * a1i + a2i * a1r,
            a2r * b1r - a2i * b1i + b2r, a2r * b1i + a2i * b1r + b2i)


def s5_run(inputs, state0, par):
    (u,) = inputs
    ab_re, ab_im, bb_re, bb_im, c_re, c_im = par
    bu_re = jnp.einsum('gph,btgh->btgp', bb_re, u)
    bu_im = jnp.einsum('gph,btgh->btgp', bb_im, u)
    a_re = jnp.broadcast_to(ab_re, bu_re.shape)
    a_im = jnp.broadcast_to(ab_im, bu_im.shape)
    ar, ai, sr, si = lax.associative_scan(complex_affine_combine, (a_re, a_im, bu_re, bu_im), axis=1)
    s0r, s0i = state0
    s_re = sr + ar * s0r[:, None] - ai * s0i[:, None]
    s_im = si + ar * s0i[:, None] + ai * s0r[:, None]
    y = jnp.einsum('ghp,btgp->btgh', c_re, s_re) - jnp.einsum('ghp,btgp->btgh', c_im, s_im)
    return y, (s_re[:, -1], s_im[:, -1])


def s5_mixer(u_ctx, u_lat, lam_re, lam_im, log_dt, b_re, b_im, c_re, c_im, d, glu_w, glu_b):
    def par(i):
        ab_re, ab_im, bb_re, bb_im = s5_discretise(lam_re[i].astype(F32), lam_im[i].astype(F32),
                                                   log_dt[i].astype(F32), b_re[i].astype(F32),
                                                   b_im[i].astype(F32))
        return (ab_re, ab_im, bb_re, bb_im, c_re[i].astype(F32), c_im[i].astype(F32))

    def grp(u):
        return u.astype(F32).reshape(u.shape[0], u.shape[1], S5_GROUPS, S5_GROUP)

    uc, ul = grp(u_ctx), grp(u_lat)
    zeros = jnp.zeros((u_lat.shape[0], S5_GROUPS, S5_STATE), F32)
    run_f = functools.partial(s5_run, par=par(0))
    run_b = functools.partial(s5_run, par=par(1))
    y_ctx, y_lat = bidirectional(run_f, run_b, (uc,), (ul,), (uc,), (ul,), (zeros, zeros))

    def out(y, u):
        y = jax.nn.gelu(y + d.astype(F32) * u).reshape(u.shape[0], u.shape[1], S5_WIDTH)
        return y * jax.nn.sigmoid(y @ glu_w.astype(F32) + glu_b.astype(F32))

    return out(y_ctx, uc), out(y_lat, ul)


def gdn_run(inputs, state0):
    q, k, v, g, beta = (to_chunks(a) for a in inputs)
    tri = jnp.tril(jnp.ones((CHUNK, CHUNK), dtype=bool))
    strict = jnp.tril(jnp.ones((CHUNK, CHUNK), dtype=bool), -1)
    eye = jnp.eye(CHUNK, dtype=F32)
    gc = jnp.cumsum(g, axis=-1)
    diff = gc[..., :, None] - gc[..., None, :]
    decay = jnp.where(tri, jnp.exp(jnp.where(tri, diff, 0.0)), 0.0)
    kb = k * beta[..., None]
    vb = v * beta[..., None]
    m = jnp.where(strict, jnp.einsum('bhnid,bhnjd->bhnij', kb, k) * decay, 0.0)
    t_inv = lax.linalg.triangular_solve(eye + m, jnp.broadcast_to(eye, m.shape),
                                        left_side=True, lower=True, unit_diagonal=True)
    u = t_inv @ vb
    w = t_inv @ (kb * jnp.exp(gc)[..., None])
    qk = jnp.where(tri, jnp.einsum('bhnid,bhnjd->bhnij', q, k) * decay, 0.0)
    q_dec = q * jnp.exp(gc)[..., None]
    k_dec = k * jnp.exp(gc[..., -1:] - gc)[..., None]
    g_tot = jnp.exp(gc[..., -1])

    def step(state, xs):
        w_c, u_c, qk_c, qd_c, kd_c, gt_c = xs
        v_new = u_c - w_c @ state
        o = qd_c @ state + qk_c @ v_new
        state = state * gt_c[..., None, None] + jnp.einsum('bhcd,bhce->bhde', kd_c, v_new)
        return state, o

    xs = tuple(jnp.moveaxis(a, 2, 0) for a in (w, u, qk, q_dec, k_dec, g_tot))
    s_fin, o = lax.scan(step, state0, xs)
    return from_chunks(jnp.moveaxis(o, 0, 2)), s_fin


def gdn_prepare(q, k, v, a, b, conv_w, a_log, dt_bias):
    bsz, t = q.shape[:2]
    qkv = short_conv(jnp.concatenate([q, k, v], axis=-1), conv_w)
    q, k, v = jnp.split(qkv, [GDN_HEADS * GDN_DK, 2 * GDN_HEADS * GDN_DK], axis=-1)
    q = l2norm(q.reshape(bsz, t, GDN_HEADS, GDN_DK)) * GDN_DK ** -0.5
    k = l2norm(k.reshape(bsz, t, GDN_HEADS, GDN_DK))
    v = v.reshape(bsz, t, GDN_HEADS, GDN_DV)
    a = a.astype(F32).reshape(bsz, t, 2, GDN_HEADS)
    b = b.astype(F32).reshape(bsz, t, 2, GDN_HEADS)
    g = -jnp.exp(a_log.astype(F32)) * jax.nn.softplus(a + dt_bias.astype(F32))
    beta = jax.nn.sigmoid(b)
    return (q, k, v, g[:, :, 0], beta[:, :, 0]), (q, k, v, g[:, :, 1], beta[:, :, 1])


def gdn_mixer(ctx_parts, lat_parts, conv_w, a_log, dt_bias, norm):
    cq, ck, cv, cz, ca, cb = ctx_parts
    lq, lk, lv, lz, la, lb = lat_parts
    c_f, c_b = gdn_prepare(cq, ck, cv, ca, cb, conv_w, a_log, dt_bias)
    l_f, l_b = gdn_prepare(lq, lk, lv, la, lb, conv_w, a_log, dt_bias)
    s0 = jnp.zeros((lq.shape[0], GDN_HEADS, GDN_DK, GDN_DV), F32)
    o_ctx, o_lat = bidirectional(gdn_run, gdn_run, c_f, l_f, c_b, l_b, s0)

    def gate_out(o, z):
        z = z.astype(F32).reshape(o.shape)
        return (rms_norm(o, norm) * jax.nn.silu(z)).reshape(o.shape[0], o.shape[1], GDN_WIDTH)

    return gate_out(o_ctx, cz), gate_out(o_lat, lz)


def mlstm_run(inputs, state0):
    q, k, v, ig, lf = (to_chunks(a) for a in inputs)
    tri = jnp.tril(jnp.ones((CHUNK, CHUNK), dtype=bool))
    b = jnp.cumsum(lf, axis=-1)
    log_d = jnp.where(tri, b[..., :, None] - b[..., None, :] + ig[..., None, :], -jnp.inf)
    m_intra = jnp.max(log_d, axis=-1)
    s = jnp.einsum('bhnid,bhnjd->bhnij', q, k) * jnp.exp(log_d - m_intra[..., None])
    num_intra = s @ v
    den_intra = jnp.sum(s, axis=-1)
    log_w = b[..., -1:] - b + ig
    m_chunk = jnp.max(log_w, axis=-1)
    wk = k * jnp.exp(log_w - m_chunk[..., None])[..., None]
    kv_chunk = jnp.einsum('bhncd,bhnce->bhnde', wk, v)
    k_chunk = jnp.sum(wk, axis=-2)
    b_tot = b[..., -1]

    def step(carry, xs):
        c_st, n_st, m_st = carry
        q_c, b_c, mi_c, ni_c, di_c, kv_c, kc_c, bt_c, mc_c = xs
        m_t = jnp.maximum(b_c + m_st[..., None], mi_c)
        inter = jnp.exp(b_c + m_st[..., None] - m_t)
        intra = jnp.exp(mi_c - m_t)
        num = inter[..., None] * (q_c @ c_st) + intra[..., None] * ni_c
        den = inter * jnp.einsum('bhcd,bhd->bhc', q_c, n_st) + intra * di_c
        h = num / jnp.maximum(jnp.abs(den), jnp.exp(-m_t))[..., None]
        m_new = jnp.maximum(bt_c + m_st, mc_c)
        a_old = jnp.exp(bt_c + m_st - m_new)
        a_new = jnp.exp(mc_c - m_new)
        c_st = a_old[..., None, None] * c_st + a_new[..., None, None] * kv_c
        n_st = a_old[..., None] * n_st + a_new[..., None] * kc_c
        return (c_st, n_st, m_new), h

    xs = tuple(jnp.moveaxis(a, 2, 0) for a in
               (q, b, m_intra, num_intra, den_intra, kv_chunk, k_chunk, b_tot, m_chunk))
    state, h = lax.scan(step, state0, xs)
    return from_chunks(jnp.moveaxis(h, 0, 2)), state


def mlstm_prepare(q, k, v, i, f, i_bias, f_bias):
    bsz, t = q.shape[:2]
    q = q.astype(F32).reshape(bsz, t, MLSTM_HEADS, MLSTM_DK) * MLSTM_DK ** -0.5
    k = k.astype(F32).reshape(bsz, t, MLSTM_HEADS, MLSTM_DK)
    v = v.astype(F32).reshape(bsz, t, MLSTM_HEADS, MLSTM_DV)
    ig = i.astype(F32).reshape(bsz, t, 2, MLSTM_HEADS) + i_bias.astype(F32)
    lf = jax.nn.log_sigmoid(f.astype(F32).reshape(bsz, t, 2, MLSTM_HEADS) + f_bias.astype(F32))
    return (q, k, v, ig[:, :, 0], lf[:, :, 0]), (q, k, v, ig[:, :, 1], lf[:, :, 1])


def mlstm_mixer(ctx_parts, lat_parts, rows, i_bias, f_bias, norm):
    cq, ck, cv, co, ci, cf = ctx_parts
    lq, lk, lv, lo, li, lf = lat_parts
    c_f, c_b = mlstm_prepare(cq, ck, cv, ci, cf, i_bias, f_bias)
    l_f, l_b = mlstm_prepare(lq, lk, lv, li, lf, i_bias, f_bias)
    l_f = tuple(to_col_major(a, rows) for a in l_f)
    l_b = tuple(to_col_major(a, rows) for a in l_b)
    bsz = lq.shape[0]
    s0 = (jnp.zeros((bsz, MLSTM_HEADS, MLSTM_DK, MLSTM_DV), F32),
          jnp.zeros((bsz, MLSTM_HEADS, MLSTM_DK), F32),
          jnp.zeros((bsz, MLSTM_HEADS), F32))
    h_ctx, h_lat = bidirectional(mlstm_run, mlstm_run, c_f, l_f, c_b, l_b, s0)
    h_lat = from_col_major(h_lat, rows)

    def gate_out(h, o):
        o = o.astype(F32).reshape(h.shape)
        return (rms_norm(h, norm) * jax.nn.sigmoid(o)).reshape(h.shape[0], h.shape[1], MLSTM_WIDTH)

    return gate_out(h_ctx, co), gate_out(h_lat, lo)


def token_mixer(h_ctx, h_lat, rows, w_in, s5_lam_re, s5_lam_im, s5_log_dt, s5_b_re, s5_b_im,
                s5_c_re, s5_c_im, s5_d, s5_glu_w, s5_glu_b, gdn_conv_w, gdn_a_log, gdn_dt_bias,
                gdn_norm, mlstm_i_bias, mlstm_f_bias, mlstm_norm):
    pc = split_cols(h_ctx @ w_in)
    pl = split_cols(h_lat @ w_in)
    s5_c, s5_l = s5_mixer(pc[0], pl[0], s5_lam_re, s5_lam_im, s5_log_dt, s5_b_re, s5_b_im,
                          s5_c_re, s5_c_im, s5_d, s5_glu_w, s5_glu_b)
    gdn_c, gdn_l = gdn_mixer(pc[1:7], pl[1:7], gdn_conv_w, gdn_a_log, gdn_dt_bias, gdn_norm)
    ml_c, ml_l = mlstm_mixer(pc[7:13], pl[7:13], rows, mlstm_i_bias, mlstm_f_bias, mlstm_norm)
    mix_ctx = jnp.concatenate([s5_c, gdn_c, ml_c], axis=-1).astype(h_ctx.dtype)
    mix_lat = jnp.concatenate([s5_l, gdn_l, ml_l], axis=-1).astype(h_lat.dtype)
    return mix_ctx, mix_lat


def setup_inputs(seed: int = 0) -> dict:
    key = jax.random.key(seed)
    ks = jax.random.split(key, 32)
    L, D, G, P, Hg = DEPTH, D_MODEL, S5_GROUPS, S5_STATE, S5_GROUP

    def nrm(i, shape, std):
        return std * jax.random.normal(ks[i], shape, F32)

    def gain(i, shape):
        return 1.0 + 0.02 * jax.random.normal(ks[i], shape, F32)

    dt_gdn = jnp.exp(jax.random.uniform(ks[23], (L, 2, GDN_HEADS), F32, math.log(1e-3), math.log(1e-1)))
    return {
        'x': nrm(0, (BATCH, SEQ, D), 1.0),
        'c': nrm(1, (BATCH, D), 1.0),
        'ctx': nrm(2, (BATCH, CTX_LEN, D), 1.0),
        'c_ctx': nrm(3, (D,), 1.0),
        'ada_w': nrm(4, (L, D, 6 * D), 0.5 * D ** -0.5),
        'ada_b': nrm(5, (L, 6 * D), 0.01),
        'norm_mix_pre': gain(6, (L, D)),
        'norm_mix_post': gain(7, (L, D)),
        'norm_ffn_pre': gain(8, (L, D)),
        'norm_ffn_post': gain(9, (L, D)),
        'w_in': nrm(10, (L, D, IN_COLS), D ** -0.5),
        'w_out': nrm(11, (L, D, D), D ** -0.5),
        's5_lam_re': -0.5 + nrm(12, (L, 2, G, P), 0.01),
        's5_lam_im': math.pi * jnp.arange(P, dtype=F32) + nrm(13, (L, 2, G, P), 0.01),
        's5_log_dt': jax.random.uniform(ks[14], (L, 2, G), F32, math.log(1e-3), math.log(1e-1)),
        's5_b_re': nrm(15, (L, 2, G, P, Hg), (2 * Hg) ** -0.5),
        's5_b_im': nrm(16, (L, 2, G, P, Hg), (2 * Hg) ** -0.5),
        's5_c_re': nrm(17, (L, 2, G, Hg, P), P ** -0.5),
        's5_c_im': nrm(18, (L, 2, G, Hg, P), P ** -0.5),
        's5_d': nrm(19, (L, G, Hg), 1.0),
        's5_glu_w': nrm(20, (L, S5_WIDTH, S5_WIDTH), S5_WIDTH ** -0.5),
        's5_glu_b': nrm(21, (L, S5_WIDTH), 0.01),
        'gdn_conv_w': nrm(22, (L, GDN_CONV, 2 * GDN_HEADS * GDN_DK + GDN_HEADS * GDN_DV), GDN_CONV ** -0.5),
        'gdn_a_log': jnp.log(jax.random.uniform(ks[24], (L, 2, GDN_HEADS), F32, 1.0, 16.0)),
        'gdn_dt_bias': dt_gdn + jnp.log(-jnp.expm1(-dt_gdn)),
        'gdn_norm': gain(25, (L, GDN_DV)),
        'mlstm_i_bias': nrm(26, (L, 2, MLSTM_HEADS), 0.1),
        'mlstm_f_bias': jnp.linspace(3.0, 6.0, MLSTM_HEADS, dtype=F32) + nrm(27, (L, 2, MLSTM_HEADS), 0.01),
        'mlstm_norm': gain(28, (L, MLSTM_DV)),
        'ffn_w_gate': nrm(29, (L, D, FFN_HIDDEN), D ** -0.5),
        'ffn_w_up': nrm(30, (L, D, FFN_HIDDEN), D ** -0.5),
        'ffn_w_down': nrm(31, (L, FFN_HIDDEN, D), FFN_HIDDEN ** -0.5),
    }


def reference(x, c, ctx, c_ctx, ada_w, ada_b, norm_mix_pre, norm_mix_post, norm_ffn_pre, norm_ffn_post,
              w_in, w_out, s5_lam_re, s5_lam_im, s5_log_dt, s5_b_re, s5_b_im, s5_c_re, s5_c_im, s5_d,
              s5_glu_w, s5_glu_b, gdn_conv_w, gdn_a_log, gdn_dt_bias, gdn_norm, mlstm_i_bias,
              mlstm_f_bias, mlstm_norm, ffn_w_gate, ffn_w_up, ffn_w_down):
    rows = x.shape[1] // GRID_W
    x_lat, x_ctx = x, ctx
    for l in range(DEPTH):
        mods = jnp.split(jax.nn.silu(c) @ ada_w[l] + ada_b[l], 6, axis=-1)
        sh_m, sc_m, gt_m, sh_f, sc_f, gt_f = (m[:, None, :] for m in mods)
        c_sh_m, c_sc_m, c_gt_m, c_sh_f, c_sc_f, c_gt_f = jnp.split(
            jax.nn.silu(c_ctx) @ ada_w[l] + ada_b[l], 6, axis=-1)

        h_lat = modulate(x_lat, norm_mix_pre[l], sh_m, sc_m)
        h_ctx = modulate(x_ctx, norm_mix_pre[l], c_sh_m, c_sc_m)
        mix_ctx, mix_lat = token_mixer(
            h_ctx, h_lat, rows, w_in[l], s5_lam_re[l], s5_lam_im[l], s5_log_dt[l], s5_b_re[l],
            s5_b_im[l], s5_c_re[l], s5_c_im[l], s5_d[l], s5_glu_w[l], s5_glu_b[l], gdn_conv_w[l],
            gdn_a_log[l], gdn_dt_bias[l], gdn_norm[l], mlstm_i_bias[l], mlstm_f_bias[l], mlstm_norm[l])

        x_lat = x_lat + gt_m * rms_norm(mix_lat @ w_out[l], norm_mix_post[l])
        f_lat = swiglu(modulate(x_lat, norm_ffn_pre[l], sh_f, sc_f), ffn_w_gate[l], ffn_w_up[l], ffn_w_down[l])
        x_lat = x_lat + gt_f * rms_norm(f_lat, norm_ffn_post[l])

        if l < DEPTH - 1:
            x_ctx = x_ctx + c_gt_m * rms_norm(mix_ctx @ w_out[l], norm_mix_post[l])
            f_ctx = swiglu(modulate(x_ctx, norm_ffn_pre[l], c_sh_f, c_sc_f),
                           ffn_w_gate[l], ffn_w_up[l], ffn_w_down[l])
            x_ctx = x_ctx + c_gt_f * rms_norm(f_ctx, norm_ffn_post[l])
    return x_lat
```

```cpp
#include <hip/hip_runtime.h>
#include <cstdio>
#include <cstdint>
namespace pg8 {
#define PG8_LAS __attribute__((address_space(3)))
typedef unsigned short bf16_t;
typedef short bf16x8 __attribute__((ext_vector_type(8)));
typedef float f32x4 __attribute__((ext_vector_type(4)));
typedef unsigned u32x4 __attribute__((ext_vector_type(4)));
constexpr int BM = 256, BK = 64, HALF = 128, HTB = HALF * BK * 2  , STAGE_BYTES = 8 * HTB, NXCD = 8, WGM = 8;

__host__ __device__ __forceinline__ int lds_byte(int r, int c) { const int st = (r >> 4) * 2 + (c >> 5), rr = r & 15, cc = c & 31, ob = rr * 64 + cc * 2; return st * 1024 + (ob ^ (((ob >> 9) & 1) << 5)); }
__host__ __device__ __forceinline__ void stage_rc(int b, int& R, int& C) { const int st = b / 1024, sb = b % 1024, swz = sb ^ (((sb >> 9) & 1) << 5); R = (st >> 1) * 16 + swz / 64; C = (st & 1) * 32 + (swz % 64) / 2; }
__host__ __device__ __forceinline__ int perm32(int rho) { const int n = rho >> 4, i = rho & 15; return 8 * (i >> 2) + 4 * n + (i & 3); }

struct Unit { int pm, pn; };
struct Gemm { const bf16_t* A; const bf16_t* Bt; int M, N, K; };

struct StaticOrder {
    int nM, nN, nwg, G, c;
    __host__ __device__ void init(int M, int N, int G_, int c_) { nM = M / BM; nN = N / BM; nwg = nM * nN; G = G_; c = c_; }
    __host__ __device__ bool next(int i, Unit& u) const {
        const long L = (long)i * G + c; if (L >= nwg) return false;
        int wgid = (int)L; { const int q = nwg / NXCD, r = nwg % NXCD, xcd = wgid % NXCD, off = wgid / NXCD; wgid = (xcd < r ? xcd * (q + 1) : r * (q + 1) + (xcd - r) * q) + off; }
        const int nig = WGM * nN, gid = wgid / nig, fm = gid * WGM, gsz = (nM - fm) < WGM ? (nM - fm) : WGM;
        u.pm = fm + ((wgid % nig) % gsz); u.pn = (wgid % nig) / gsz; return true;
    }
    __device__ __forceinline__ void a_ready(const Unit&) const {}
    __device__ __forceinline__ void done(const Unit&) const {}
};

__device__ __forceinline__ unsigned cvt_pk_bf16(float lo, float hi) { unsigned r; asm volatile("v_cvt_pk_bf16_f32 %0, %1, %2" : "=v"(r) : "v"(lo), "v"(hi)); return r; }
__device__ __forceinline__ float bf_lo(unsigned w) { return __uint_as_float(w << 16); }
__device__ __forceinline__ float bf_hi(unsigned w) { return __uint_as_float(w & 0xffff0000u); }
__device__ __forceinline__ float sigmoidf_(float x) { return 1.0f / (1.0f + __expf(-x)); }

struct EpiF32 {
    static constexpr bool PERM = false, AFTER_DRAIN = false;
    float* C; int ldc;
    __device__ __forceinline__ void operator()(const f32x4 (&acc)[2][2][4][2], const Unit& u, int wr, int wc, int fr, int fq) const {
        const int row0 = u.pm * BM + wr * 64 + fr, col0 = u.pn * BM + wc * 32 + 4 * fq;
#pragma unroll
        for (int ai = 0; ai < 2; ++ai)
#pragma unroll
            for (int m = 0; m < 4; ++m) { float* rowp = C + (size_t)(row0 + ai * HALF + m * 16) * ldc + col0;
#pragma unroll
                for (int bj = 0; bj < 2; ++bj)
#pragma unroll
                    for (int n = 0; n < 2; ++n) *(f32x4*)(rowp + bj * HALF + n * 16) = acc[ai][bj][m][n]; }
    }
};
struct EpiProj {
    static constexpr bool PERM = true, AFTER_DRAIN = false;
    bf16_t* P; int ldp; float* G; int gate_tile;
    __device__ __forceinline__ void operator()(const f32x4 (&acc)[2][2][4][2], const Unit& u, int wr, int wc, int fr, int fq) const {
        const int row0 = u.pm * BM + wr * 64 + fr;
        if (u.pn != gate_tile) {
            const int col0 = u.pn * BM + wc * 32 + 8 * fq;
#pragma unroll
            for (int ai = 0; ai < 2; ++ai)
#pragma unroll
                for (int m = 0; m < 4; ++m) { bf16_t* rowp = P + (size_t)(row0 + ai * HALF + m * 16) * ldp + col0;
#pragma unroll
                    for (int bj = 0; bj < 2; ++bj) { const f32x4 v0 = acc[ai][bj][m][0], v1 = acc[ai][bj][m][1];
                        u32x4 w; w.x = cvt_pk_bf16(v0[0], v0[1]); w.y = cvt_pk_bf16(v0[2], v0[3]); w.z = cvt_pk_bf16(v1[0], v1[1]); w.w = cvt_pk_bf16(v1[2], v1[3]);
                        *(u32x4*)(rowp + bj * HALF) = w; } }
        } else {
            const int col0 = wc * 32 + 8 * fq;
#pragma unroll
            for (int ai = 0; ai < 2; ++ai)
#pragma unroll
                for (int m = 0; m < 4; ++m) { float* rowp = G + (size_t)(row0 + ai * HALF + m * 16) * 128 + col0;
                    *(f32x4*)(rowp) = acc[ai][0][m][0]; *(f32x4*)(rowp + 4) = acc[ai][0][m][1]; }
        }
    }
};
struct EpiSwiGLU {
    static constexpr bool PERM = true, AFTER_DRAIN = false;
    bf16_t* O; int ldc;
    __device__ __forceinline__ void operator()(const f32x4 (&acc)[2][2][4][2], const Unit& u, int wr, int wc, int fr, int fq) const {
        const int row0 = u.pm * BM + wr * 64 + fr, col0 = u.pn * HALF + wc * 32 + 8 * fq;
#pragma unroll
        for (int ai = 0; ai < 2; ++ai)
#pragma unroll
            for (int m = 0; m < 4; ++m) { bf16_t* rowp = O + (size_t)(row0 + ai * HALF + m * 16) * ldc + col0;
                float r[8];
#pragma unroll
                for (int n = 0; n < 2; ++n)
#pragma unroll
                    for (int j = 0; j < 4; ++j) { const float g = acc[ai][0][m][n][j], up = acc[ai][1][m][n][j]; r[n * 4 + j] = g * sigmoidf_(g) * up; }
                u32x4 w; w.x = cvt_pk_bf16(r[0], r[1]); w.y = cvt_pk_bf16(r[2], r[3]); w.z = cvt_pk_bf16(r[4], r[5]); w.w = cvt_pk_bf16(r[6], r[7]);
                *(u32x4*)rowp = w; }
    }
};
struct EpiGlu {
    static constexpr bool PERM = true, AFTER_DRAIN = false;
    const bf16_t* Y; int ldy; bf16_t* O; int ldo; const float* bias;
    __device__ __forceinline__ void operator()(const f32x4 (&acc)[2][2][4][2], const Unit& u, int wr, int wc, int fr, int fq) const {
        const int row0 = u.pm * BM + wr * 64 + fr, col0 = u.pn * BM + wc * 32 + 8 * fq;
        f32x4 bv[2][2];
#pragma unroll
        for (int bj = 0; bj < 2; ++bj)
#pragma unroll
            for (int n = 0; n < 2; ++n) bv[bj][n] = *(const f32x4*)(bias + col0 + bj * HALF + 4 * n);
#pragma unroll
        for (int ai = 0; ai < 2; ++ai)
#pragma unroll
            for (int m = 0; m < 4; ++m) { const size_t row = (size_t)(row0 + ai * HALF + m * 16);
#pragma unroll
                for (int bj = 0; bj < 2; ++bj) {
                    const u32x4 yv = *(const u32x4*)(Y + row * ldy + col0 + bj * HALF);
                    const f32x4 v0 = acc[ai][bj][m][0] + bv[bj][0], v1 = acc[ai][bj][m][1] + bv[bj][1];
                    u32x4 w;
                    w.x = cvt_pk_bf16(bf_lo(yv.x) * sigmoidf_(v0[0]), bf_hi(yv.x) * sigmoidf_(v0[1]));
                    w.y = cvt_pk_bf16(bf_lo(yv.y) * sigmoidf_(v0[2]), bf_hi(yv.y) * sigmoidf_(v0[3]));
                    w.z = cvt_pk_bf16(bf_lo(yv.z) * sigmoidf_(v1[0]), bf_hi(yv.z) * sigmoidf_(v1[1]));
                    w.w = cvt_pk_bf16(bf_lo(yv.w) * sigmoidf_(v1[2]), bf_hi(yv.w) * sigmoidf_(v1[3]));
                    *(u32x4*)(O + row * ldo + col0 + bj * HALF) = w; } }
    }
};

template <class Epi, class Sched, bool ALIGN_EPI = false, bool SP2 = false>
__device__ __forceinline__ void gemm_phase(PG8_LAS unsigned char* lds, const Gemm g, const Sched& S, const Epi& E) {
    int tid_ = threadIdx.x; asm volatile("" : "+v"(tid_));
    const int tid = tid_, wid = __builtin_amdgcn_readfirstlane(tid >> 6), lane = tid & 63, wr = wid >> 2, wc = wid & 3, fr = lane & 15, fq = lane >> 4;
    const int K = g.K, nt = K / BK;
    unsigned voffA[2], voffB[2];
#pragma unroll
    for (int i = 0; i < 2; ++i) { int R, C; stage_rc(tid * 16 + i * 8192, R, C); const int Rb = Epi::PERM ? ((R & ~31) + perm32(R & 31)) : R;
        voffA[i] = (unsigned)(R * K + C) * 2u; voffB[i] = (unsigned)(Rb * K + C) * 2u; }
    const size_t kstep = (size_t)(BK * 2);
    const size_t hstep = (size_t)HALF * K * 2;
    const size_t tstep = 2 * hstep;
    const unsigned ldsw = (unsigned)wid * 1024u;
    const int aoff = lds_byte(wr * 64 + fr, fq * 8), boff = lds_byte(wc * 32 + fr, fq * 8);
#define PG8_SA(b, h) (((b) * 2 + (h)) * HTB)
#define PG8_SB(b, h) ((4 + (b) * 2 + (h)) * HTB)
#define PG8_STAGE(bufoff, gbase, voff) do { _Pragma("unroll") for (int _i = 0; _i < 2; ++_i) \
        __builtin_amdgcn_global_load_lds((const unsigned*)((const char*)(gbase) + (voff)[_i]), (PG8_LAS unsigned*)(lds + (bufoff) + ldsw + _i * 8192), 16, 0, 0); } while (0)
#define PG8_LDA(dst, b, h) do { _Pragma("unroll") for (int m = 0; m < 4; ++m) _Pragma("unroll") for (int k = 0; k < 2; ++k) dst[m][k] = *(const PG8_LAS bf16x8*)(lds + PG8_SA(b, h) + aoff + m * 2048 + k * 1024); } while (0)
#define PG8_LDB(dst, b, h) do { _Pragma("unroll") for (int n = 0; n < 2; ++n) _Pragma("unroll") for (int k = 0; k < 2; ++k) dst[n][k] = *(const PG8_LAS bf16x8*)(lds + PG8_SB(b, h) + boff + n * 2048 + k * 1024); } while (0)
#define PG8_MMA(ai, bj, At, Bt) do { __builtin_amdgcn_s_setprio(1); _Pragma("unroll") for (int m = 0; m < 4; ++m) _Pragma("unroll") for (int n = 0; n < 2; ++n) _Pragma("unroll") for (int k = 0; k < 2; ++k) \
        acc[ai][bj][m][n] = __builtin_amdgcn_mfma_f32_16x16x32_bf16(Bt[n][k], At[m][k], acc[ai][bj][m][n], 0, 0, 0); __builtin_amdgcn_s_setprio(0); } while (0)
#define PG8_WAIT_V(n) asm volatile("s_waitcnt vmcnt(" #n ")" ::: "memory")
#define PG8_WAIT_L(n) asm volatile("s_waitcnt lgkmcnt(" #n ")" ::: "memory")
#define PG8_BAR __builtin_amdgcn_s_barrier()
#define PG8_SCHED __builtin_amdgcn_sched_barrier(0)
    Unit cur, nxt; int ui = 0;
    if (!S.next(0, cur)) return;
    f32x4 acc[2][2][4][2];
#pragma unroll
    for (int a = 0; a < 2; ++a)
#pragma unroll
        for (int b = 0; b < 2; ++b)
#pragma unroll
            for (int m = 0; m < 4; ++m)
#pragma unroll
                for (int n = 0; n < 2; ++n) acc[a][b][m][n] = (f32x4){0.f, 0.f, 0.f, 0.f};
    bf16x8 At[4][2], B0[2][2], B1[2][2];
    const char* cA = (const char*)g.A + (size_t)cur.pm * tstep; const char* cB = (const char*)g.Bt + (size_t)cur.pn * tstep;
    S.a_ready(cur);
    if constexpr (SP2) {
        PG8_STAGE(PG8_SB(0, 0), cB, voffB); PG8_STAGE(PG8_SB(0, 1), cB + hstep, voffB); PG8_STAGE(PG8_SA(0, 0), cA, voffA); PG8_STAGE(PG8_SA(0, 1), cA + hstep, voffA);
        if (wr == 1) PG8_BAR;
        PG8_WAIT_V(2); PG8_BAR;
        PG8_STAGE(PG8_SB(1, 0), cB + kstep, voffB); PG8_STAGE(PG8_SA(1, 0), cA + kstep, voffA); PG8_STAGE(PG8_SB(1, 1), cB + hstep + kstep, voffB);
        PG8_WAIT_V(6); PG8_BAR;
    } else {
        PG8_STAGE(PG8_SB(0, 0), cB, voffB); PG8_STAGE(PG8_SA(0, 0), cA, voffA); PG8_STAGE(PG8_SB(0, 1), cB + hstep, voffB); PG8_STAGE(PG8_SA(0, 1), cA + hstep, voffA);
        if (wr == 1) PG8_BAR;
        PG8_WAIT_V(4); PG8_BAR;
        PG8_STAGE(PG8_SB(1, 0), cB + kstep, voffB); PG8_STAGE(PG8_SA(1, 0), cA + kstep, voffA); PG8_STAGE(PG8_SB(1, 1), cB + hstep + kstep, voffB);
        PG8_WAIT_V(6); PG8_BAR;
    }
    for (;;) {
        const bool has_next = S.next(ui + 1, nxt);
        const char* nA = has_next ? (const char*)g.A + (size_t)nxt.pm * tstep : cA; const char* nB = has_next ? (const char*)g.Bt + (size_t)nxt.pn * tstep : cB;
        for (int t = 0; t < nt; t += 2) {
            const bool last = (t == nt - 2);
            const char* a1 = cA + (size_t)(t + 1) * kstep;
            const char* a2 = last ? nA : cA + (size_t)(t + 2) * kstep; const char* b2 = last ? nB : cB + (size_t)(t + 2) * kstep;
            const char* a3 = a2 + kstep; const char* b3 = b2 + kstep;
            if (last && has_next) S.a_ready(nxt);
            if constexpr (SP2) {
            PG8_LDB(B0, 0, 0); PG8_LDB(B1, 0, 1); PG8_SCHED; PG8_LDA(At, 0, 0); PG8_STAGE(PG8_SA(1, 1), a1 + hstep, voffA);
            PG8_WAIT_V(8); PG8_WAIT_L(0); PG8_BAR; PG8_MMA(0, 0, At, B0); PG8_MMA(0, 1, At, B1); PG8_BAR; PG8_SCHED;
            PG8_LDA(At, 0, 1); PG8_STAGE(PG8_SB(0, 0), b2, voffB); PG8_STAGE(PG8_SB(0, 1), b2 + hstep, voffB); PG8_STAGE(PG8_SA(0, 0), a2, voffA);
            PG8_WAIT_V(8); PG8_WAIT_L(0); PG8_BAR; PG8_MMA(1, 0, At, B0); PG8_MMA(1, 1, At, B1); PG8_BAR; PG8_SCHED;
            PG8_LDB(B0, 1, 0); PG8_LDB(B1, 1, 1); PG8_SCHED; PG8_LDA(At, 1, 0); PG8_STAGE(PG8_SA(0, 1), a2 + hstep, voffA);
            PG8_WAIT_V(8); PG8_WAIT_L(0); PG8_BAR; PG8_MMA(0, 0, At, B0); PG8_MMA(0, 1, At, B1); PG8_BAR; PG8_SCHED;
            PG8_LDA(At, 1, 1); PG8_STAGE(PG8_SB(1, 0), b3, voffB); PG8_STAGE(PG8_SB(1, 1), b3 + hstep, voffB); PG8_STAGE(PG8_SA(1, 0), a3, voffA);
            PG8_WAIT_V(8); PG8_WAIT_L(0); PG8_BAR; PG8_MMA(1, 0, At, B0); PG8_MMA(1, 1, At, B1); PG8_BAR; PG8_SCHED;
            } else {
            PG8_LDB(B0, 0, 0); PG8_SCHED; PG8_LDA(At, 0, 0); PG8_STAGE(PG8_SA(1, 1), a1 + hstep, voffA);
            PG8_WAIT_L(8); PG8_BAR; PG8_WAIT_L(0); PG8_MMA(0, 0, At, B0); PG8_BAR; PG8_SCHED;
            PG8_LDB(B1, 0, 1); PG8_STAGE(PG8_SB(0, 0), b2, voffB);
            PG8_BAR; PG8_WAIT_L(0); PG8_MMA(0, 1, At, B1); PG8_BAR;
            PG8_LDA(At, 0, 1); PG8_STAGE(PG8_SA(0, 0), a2, voffA);
            PG8_BAR; PG8_WAIT_L(0); PG8_MMA(1, 0, At, B0); PG8_BAR; PG8_SCHED;
            PG8_STAGE(PG8_SB(0, 1), b2 + hstep, voffB);
            PG8_WAIT_V(6); PG8_BAR; PG8_MMA(1, 1, At, B1); PG8_BAR;
            PG8_LDB(B0, 1, 0); PG8_SCHED; PG8_LDA(At, 1, 0); PG8_STAGE(PG8_SA(0, 1), a2 + hstep, voffA);
            PG8_WAIT_L(8); PG8_BAR; PG8_WAIT_L(0); PG8_MMA(0, 0, At, B0); PG8_BAR; PG8_SCHED;
            PG8_LDB(B1, 1, 1); PG8_STAGE(PG8_SB(1, 0), b3, voffB);
            PG8_BAR; PG8_WAIT_L(0); PG8_MMA(0, 1, At, B1); PG8_BAR;
            PG8_LDA(At, 1, 1); PG8_STAGE(PG8_SA(1, 0), a3, voffA);
            PG8_BAR; PG8_WAIT_L(0); PG8_MMA(1, 0, At, B0); PG8_BAR; PG8_SCHED;
            PG8_STAGE(PG8_SB(1, 1), b3 + hstep, voffB);
            PG8_WAIT_V(6); PG8_BAR; PG8_MMA(1, 1, At, B1); PG8_BAR;
            }
        }
        if constexpr (ALIGN_EPI) { if (wr == 0) PG8_BAR; }
        if constexpr (!Epi::AFTER_DRAIN) { E(acc, cur, wr, wc, fr, fq); S.done(cur); }
        if (!has_next) break;
#pragma unroll
        for (int a = 0; a < 2; ++a)
#pragma unroll
            for (int b = 0; b < 2; ++b)
#pragma unroll
                for (int m = 0; m < 4; ++m)
#pragma unroll
                    for (int n = 0; n < 2; ++n) acc[a][b][m][n] = (f32x4){0.f, 0.f, 0.f, 0.f};
        cur = nxt; cA = nA; cB = nB; ++ui;
        if constexpr (ALIGN_EPI) { if (wr == 1) PG8_BAR; }
    }
    PG8_WAIT_V(0);
    if constexpr (!ALIGN_EPI) { if (wr == 0) PG8_BAR; }
    PG8_BAR;
    if constexpr (Epi::AFTER_DRAIN) { E.fused(acc, cur, wr, wc, fr, fq, lds, wid, lane); S.done(cur); }
#undef PG8_SA
#undef PG8_SB
#undef PG8_STAGE
#undef PG8_LDA
#undef PG8_LDB
#undef PG8_MMA
#undef PG8_WAIT_V
#undef PG8_WAIT_L
#undef PG8_BAR
#undef PG8_SCHED
}
}

#ifndef MK_PER_PHASE
#define MK_PER_PHASE 1
#endif
constexpr int NWAVES = 8;
constexpr int NB = 4, TL = 2048, TC = 256, D = 2048, DEPTH = 2;
constexpr int ML = NB * TL, MC = NB * TC, MA = ML + MC;
constexpr int NPROJ = 5936, N1 = 6144, LDP = 5888, GATE_TILE = 23;
constexpr int FF = 5632;
constexpr float EPS = 1e-6f;
constexpr int PC_U = 0, PC_GQ = 512, PC_GK = 1280, PC_GV = 2048, PC_GZ = 2816, PC_MQ = 3584, PC_MK = 3968, PC_MV = 4352, PC_MO = 5120;
constexpr int GC_A = 0, GC_B = 12, GC_I = 24, GC_F = 36;
enum { I_X = 0, I_C, I_CTX, I_CCTX, I_ADAW, I_ADAB, I_NMPRE, I_NMPOST, I_NFPRE, I_NFPOST, I_WIN, I_WOUT, I_LAMRE, I_LAMIM, I_LOGDT, I_BRE, I_BIM, I_CRE, I_CIM, I_S5D,
       I_GLUW, I_GLUB, I_CONVW, I_ALOG, I_DTB, I_GNORM, I_IB, I_FB, I_MNORM, I_WG, I_WU, I_WD, N_IN };

constexpr size_t MiB = 1u << 20;
constexpr size_t WS_CTL = 0, CTL_ZERO_BYTES = 64 * 1024;
constexpr size_t WS_MODS = 1 * MiB;
constexpr size_t WS_W = 2 * MiB, W_LAYER = 99 * MiB;
constexpr size_t WO_OFF = 24 * MiB, WGU_OFF = 32 * MiB, WD_OFF = 76 * MiB, WGLU_OFF = 98 * MiB;
constexpr size_t WS_XBUF = WS_W + 2 * W_LAYER;
constexpr size_t WS_ABUF = WS_XBUF + 72 * MiB;
constexpr size_t WS_PBUF = WS_ABUF + 36 * MiB;
constexpr size_t WS_GBUF = WS_PBUF + 104 * MiB;
constexpr size_t WS_YS5 = WS_GBUF + 5 * MiB;
constexpr size_t WS_OG = WS_YS5 + 36 * MiB;
constexpr size_t WS_HM = WS_OG + 54 * MiB;
constexpr size_t WS_MIX = WS_HM + 54 * MiB;
constexpr size_t WS_Y5 = WS_MIX + 36 * MiB;
constexpr size_t WS_R = WS_Y5 + 9 * MiB;
constexpr size_t WS_END = WS_R + 72 * MiB;
static_assert(WS_END <= 768 * MiB, "workspace map");
constexpr int CW_TMO = 0, CW_BAR = 4096;

constexpr int RING_BYTES = 131072, LDSCTL_OFF = RING_BYTES, MISC_OFF = LDSCTL_OFF + 320, LDS_BYTES = 147456;

#define GAS __attribute__((address_space(1)))
#define LAS __attribute__((address_space(3)))
typedef unsigned short bf16;
typedef unsigned v4u __attribute__((ext_vector_type(4)));
typedef unsigned v2u __attribute__((ext_vector_type(2)));
typedef float f32x4 __attribute__((ext_vector_type(4)));
typedef float f32x2 __attribute__((ext_vector_type(2)));
typedef GAS unsigned gu32;
#define RLX_AGENT __ATOMIC_RELAXED, __HIP_MEMORY_SCOPE_AGENT
#define LDS_WAIT() asm volatile("s_waitcnt lgkmcnt(0)" ::: "memory")
#define VM_WAIT() asm volatile("s_waitcnt vmcnt(0)" ::: "memory")
__device__ __forceinline__ unsigned f2bf(float f) { unsigned u = __builtin_bit_cast(unsigned, f); return (u + 0x7fffu + ((u >> 16) & 1u)) >> 16; }
__device__ __forceinline__ unsigned pk2(float lo, float hi) { return f2bf(lo) | (f2bf(hi) << 16); }
__device__ __forceinline__ float bflo(unsigned w) { return __uint_as_float(w << 16); }
__device__ __forceinline__ float bfhi(unsigned w) { return __uint_as_float(w & 0xffff0000u); }
__device__ __forceinline__ float sigm(float x) { return 1.0f / (1.0f + __expf(-x)); }
__device__ __forceinline__ float siluf(float x) { return x * sigm(x); }
__device__ __forceinline__ float softplusf(float x) { return x > 20.f ? x : log1pf(expf(x)); }
__device__ __forceinline__ float logsigmoidf(float x) { return fminf(x, 0.f) - log1pf(expf(-fabsf(x))); }
__device__ __forceinline__ float gelu_tanh(float x) { return 0.5f * x * (1.0f + tanhf(0.7978845608028654f * (x + 0.044715f * x * x * x))); }
__device__ __forceinline__ float wave_sum(float v) {
#pragma unroll
    for (int o = 1; o < 64; o <<= 1) v += __shfl_xor(v, o);
    return v;
}
#define XB_TMO      128
#define XB_XCNT(j)  (256  + 64 * (j))
#define XB_XSUB(j)  (1280 + 64 * (j))
#define XB_XGEN(j)  (2304 + 64 * (j))
#define XB_TOP      3328
#define XB_TOPGEN   3392
#define XCD_BAR_WORDS 3456
#define XB_SPIN_CAP (1u << 18)

__device__ __forceinline__ unsigned xb_ld(unsigned* p)              { return __hip_atomic_load(p, __ATOMIC_RELAXED, __HIP_MEMORY_SCOPE_AGENT); }
__device__ __forceinline__ unsigned xb_add(unsigned* p, unsigned v) { return __hip_atomic_fetch_add(p, v, __ATOMIC_RELAXED, __HIP_MEMORY_SCOPE_AGENT); }
__device__ __forceinline__ unsigned xb_xcc_id() { return (unsigned)__builtin_amdgcn_s_getreg((3 << 11) | 20) & 0xFu; }
#define XB_SPIN(cond, bar) do { unsigned _sp = 0; while (cond) { __builtin_amdgcn_s_sleep(1); \
    if ((++_sp & 255u) == 0u) { if (xb_ld(&(bar)[XB_TMO])) break; if (_sp > XB_SPIN_CAP) { atomicAdd(&(bar)[XB_TMO], 1u); break; } } } } while (0)

struct XcdBarrier {
    unsigned* bar; unsigned x;
    volatile LAS unsigned* st;
};

__device__ __forceinline__ XcdBarrier xcd_barrier_post(unsigned* bar, volatile LAS unsigned* st) {
    XcdBarrier b; b.bar = bar; b.x = xb_xcc_id(); b.st = st;
    if (threadIdx.x == 0) (void)xb_add(&bar[XB_XCNT(b.x)], 1u);
    return b;
}
__device__ __forceinline__ void xcd_barrier_complete(unsigned* bar, unsigned x, unsigned& nloc, unsigned& nx) {
    const unsigned G = gridDim.x * gridDim.y * gridDim.z;
    unsigned sum, cnt, mine, sp = 0u;
    for (;;) {
        sum = 0u; cnt = 0u; mine = 0u;
#pragma unroll
        for (unsigned j = 0; j < 16; ++j) { const unsigned c = xb_ld(&bar[XB_XCNT(j)]); sum += c; cnt += (c > 0u) ? 1u : 0u; mine = (j == x) ? c : mine; }
        if (sum == G) break;
        __builtin_amdgcn_s_sleep(1);
        if ((++sp & 255u) == 0u) { if (xb_ld(&bar[XB_TMO])) break; if (sp > XB_SPIN_CAP) { atomicAdd(&bar[XB_TMO], 1u); break; } }
    }
    nloc = mine > 0u ? mine : 1u; nx = cnt > 0u ? cnt : 1u;
}

__device__ __forceinline__ void xcd_barrier(const XcdBarrier& b) {
    asm volatile("s_waitcnt vmcnt(0)" ::: "memory");
    __syncthreads();
    if (threadIdx.x == 0) {
        unsigned* bar = b.bar;
        __builtin_amdgcn_s_waitcnt(0);
        unsigned nloc = b.st[0], nx = b.st[1];
        if (nloc == 0u) { xcd_barrier_complete(bar, b.x, nloc, nx); b.st[0] = nloc; b.st[1] = nx; }
        const unsigned old = xb_add(&bar[XB_XSUB(b.x)], 1u);
        const unsigned gen = old / nloc;
        if (old + 1u == (gen + 1u) * nloc) {
            __builtin_amdgcn_fence(__ATOMIC_RELEASE, "agent");
            asm volatile("s_waitcnt vmcnt(0)" ::: "memory");
            const unsigned og = xb_add(&bar[XB_TOP], 1u);
            const unsigned tg = og / nx;
            if (og + 1u == (tg + 1u) * nx) xb_add(&bar[XB_TOPGEN], 1u);
            else XB_SPIN(xb_ld(&bar[XB_TOPGEN]) == tg, bar);
            __builtin_amdgcn_fence(__ATOMIC_ACQUIRE, "agent");
            xb_add(&bar[XB_XGEN(b.x)], 1u);
            asm volatile("s_waitcnt vmcnt(0)" ::: "memory");
        } else {
            XB_SPIN(xb_ld(&bar[XB_XGEN(b.x)]) == gen, bar);
            __builtin_amdgcn_fence(__ATOMIC_ACQUIRE, "agent");
            asm volatile("s_waitcnt vmcnt(0)" ::: "memory");
        }
    }
    __syncthreads();
}

struct Args { const float* in[N_IN]; float* out; unsigned char* ws; int ph_lo, ph_hi, li, pad; };

template <int MODE> __device__ __forceinline__ int dst_row(int n) {
    if (MODE == 1) return n < 3584 ? n : (n < 3608 ? 5888 + (n - 3584) : (n < 5912 ? n - 24 : n));
    if (MODE == 2) return 256 * (n >> 7) + (n & 127);
    if (MODE == 3) return 256 * (n >> 7) + 128 + (n & 127);
    return n;
}
template <int MODE> __device__ __forceinline__ void transpose_item(const float* W, int K, int N, bf16* WT, LAS float* scr, int item, int lane) {
    const int nblk = (N + 31) / 32, kb = item / nblk, nb = item % nblk, k0 = 64 * kb, n0 = 32 * nb;
    const int nn = n0 + (lane & 31);
#pragma unroll 8
    for (int i = 0; i < 32; ++i) { const int kk = 2 * i + (lane >> 5); scr[kk * 33 + (lane & 31)] = nn < N ? W[(size_t)(k0 + kk) * N + nn] : 0.f; }
    LDS_WAIT(); asm volatile("" ::: "memory");
    const int c = lane & 7;
#pragma unroll
    for (int j = 0; j < 4; ++j) { const int nl = (lane >> 3) + 8 * j, n = n0 + nl; const LAS float* s = scr + (8 * c) * 33 + nl;
        v4u o; o.x = pk2(s[0 * 33], s[1 * 33]); o.y = pk2(s[2 * 33], s[3 * 33]); o.z = pk2(s[4 * 33], s[5 * 33]); o.w = pk2(s[6 * 33], s[7 * 33]);
        if (n < N) *(GAS v4u*)(WT + (size_t)dst_row<MODE>(n) * K + k0 + 8 * c) = o; }
    LDS_WAIT(); asm volatile("" ::: "memory");
}
__device__ __forceinline__ void p0_prologue(const Args& a, LAS unsigned char* lds, int tid, int lane, int wave, int bid, int G) {
    {
        LAS float* sc = (LAS float*)lds;
        LAS float* red = (LAS float*)(lds + 40960);
        float* mods = (float*)(a.ws + WS_MODS);
        for (int i = tid; i < 5 * D; i += NWAVES * 64) { const int r = i >> 11, k = i & 2047; const float v = r < 4 ? a.in[I_C][r * D + k] : a.in[I_CCTX][k]; sc[i] = siluf(v); }
        __syncthreads();
        for (int unit = bid; unit < 192; unit += G) {
            const int l = unit / 96, n0 = (unit % 96) * 128;
            const float* W = a.in[I_ADAW] + (size_t)l * D * (6 * D) + n0 + 2 * lane;
            float acc[5][2];
#pragma unroll
            for (int r = 0; r < 5; ++r) { acc[r][0] = 0.f; acc[r][1] = 0.f; }
            const int kbeg = wave * 256;
#pragma unroll 8
            for (int kk = 0; kk < 256; ++kk) { const int k = kbeg + kk; const f32x2 w = *(const f32x2*)(W + (size_t)k * (6 * D));
#pragma unroll
                for (int r = 0; r < 5; ++r) { const float s = sc[r * D + k]; acc[r][0] += s * w.x; acc[r][1] += s * w.y; } }
#pragma unroll
            for (int r = 0; r < 5; ++r) { red[(wave * 5 + r) * 128 + 2 * lane] = acc[r][0]; red[(wave * 5 + r) * 128 + 2 * lane + 1] = acc[r][1]; }
            __syncthreads();
            for (int o = tid; o < 640; o += NWAVES * 64) { const int r = o >> 7, c = o & 127; float s = 0.f;
#pragma unroll
                for (int w = 0; w < 8; ++w) s += red[(w * 5 + r) * 128 + c];
                mods[(size_t)(l * 5 + r) * (6 * D) + n0 + c] = s + a.in[I_ADAB][l * 6 * D + n0 + c]; }
            __syncthreads();
        }
    }
    {
        LAS float* scr = (LAS float*)(lds + 65536 + wave * 8448);
        const int gw = bid * NWAVES + wave, NGW = G * NWAVES;
        constexpr int IT_IN = 32 * 186, IT_OUT = 32 * 64, IT_G = 32 * 176, IT_D = 88 * 64, IT_GLU = 8 * 16, IT_LAYER = IT_IN + IT_OUT + 2 * IT_G + IT_D + IT_GLU;
        for (int it = gw; it < DEPTH * IT_LAYER; it += NGW) {
            const int l = it / IT_LAYER; int r = it % IT_LAYER; unsigned char* wl = a.ws + WS_W + (size_t)l * W_LAYER;
            if (r < IT_IN) { transpose_item<1>(a.in[I_WIN] + (size_t)l * D * NPROJ, D, NPROJ, (bf16*)wl, scr, r, lane); continue; } r -= IT_IN;
            if (r < IT_OUT) { transpose_item<0>(a.in[I_WOUT] + (size_t)l * D * D, D, D, (bf16*)(wl + WO_OFF), scr, r, lane); continue; } r -= IT_OUT;
            if (r < IT_G) { transpose_item<2>(a.in[I_WG] + (size_t)l * D * FF, D, FF, (bf16*)(wl + WGU_OFF), scr, r, lane); continue; } r -= IT_G;
            if (r < IT_G) { transpose_item<3>(a.in[I_WU] + (size_t)l * D * FF, D, FF, (bf16*)(wl + WGU_OFF), scr, r, lane); continue; } r -= IT_G;
            if (r < IT_D) { transpose_item<0>(a.in[I_WD] + (size_t)l * FF * D, FF, D, (bf16*)(wl + WD_OFF), scr, r, lane); continue; } r -= IT_D;
            transpose_item<0>(a.in[I_GLUW] + (size_t)l * 512 * 512, 512, 512, (bf16*)(wl + WGLU_OFF), scr, r, lane);
        }
        constexpr int ZV = (N1 - NPROJ) * D * 2 / 16;
        for (int i = bid * NWAVES * 64 + tid; i < DEPTH * ZV; i += G * NWAVES * 64) { const int l = i / ZV, r = i % ZV;
            *(GAS v4u*)(a.ws + WS_W + (size_t)l * W_LAYER + (size_t)NPROJ * D * 2 + (size_t)r * 16) = (v4u){0u, 0u, 0u, 0u}; }
    }
}

template <bool SRC_IN, bool HAS_R, bool WRITE_X, bool WRITE_OUT, bool MAKE_A>
__device__ __forceinline__ void rowpass(const Args& a, int gw, int NGW, int lane, int nrows, int l, int gate_chunk, const float* gpost, int la, const float* gpre, int sh_chunk, int sc_chunk) {
    const float* mods = (const float*)(a.ws + WS_MODS);
    float* xbuf = (float*)(a.ws + WS_XBUF);
    const float* R = (const float*)(a.ws + WS_R);
    bf16* A = (bf16*)(a.ws + WS_ABUF);
    for (int row = gw; row < nrows; row += NGW) {
        const int r5 = row < ML ? row / TL : 4;
        const float* xs = SRC_IN ? (row < ML ? a.in[I_X] + (size_t)row * D : a.in[I_CTX] + (size_t)(row - ML) * D) : xbuf + (size_t)row * D;
        f32x4 xv[8];
#pragma unroll
        for (int j = 0; j < 8; ++j) xv[j] = *(const f32x4*)(xs + 4 * lane + 256 * j);
        if (HAS_R) {
            f32x4 rv[8]; float ss = 0.f;
#pragma unroll
            for (int j = 0; j < 8; ++j) { rv[j] = *(const f32x4*)(R + (size_t)row * D + 4 * lane + 256 * j); ss += (rv[j].x * rv[j].x + rv[j].y * rv[j].y) + (rv[j].z * rv[j].z + rv[j].w * rv[j].w); }
            const float rstd = 1.0f / sqrtf(wave_sum(ss) * (1.0f / D) + EPS);
            const float* mg = mods + ((size_t)(l * 5 + r5) * 6 + gate_chunk) * D;
#pragma unroll
            for (int j = 0; j < 8; ++j) { const int c = 4 * lane + 256 * j; const f32x4 g = *(const f32x4*)(gpost + c), gt = *(const f32x4*)(mg + c);
                xv[j] = xv[j] + gt * (rv[j] * rstd * g);
                if (WRITE_X) *(f32x4*)(xbuf + (size_t)row * D + c) = xv[j];
                if (WRITE_OUT) *(f32x4*)(a.out + (size_t)row * D + c) = xv[j]; }
        }
        if (MAKE_A) {
            float ss = 0.f;
#pragma unroll
            for (int j = 0; j < 8; ++j) ss += (xv[j].x * xv[j].x + xv[j].y * xv[j].y) + (xv[j].z * xv[j].z + xv[j].w * xv[j].w);
            const float rstd = 1.0f / sqrtf(wave_sum(ss) * (1.0f / D) + EPS);
            const float* msh = mods + ((size_t)(la * 5 + r5) * 6 + sh_chunk) * D; const float* msc = mods + ((size_t)(la * 5 + r5) * 6 + sc_chunk) * D;
#pragma unroll
            for (int j = 0; j < 8; ++j) { const int c = 4 * lane + 256 * j; const f32x4 g = *(const f32x4*)(gpre + c), sh = *(const f32x4*)(msh + c), sc = *(const f32x4*)(msc + c);
                const f32x4 v = xv[j] * rstd * g * (sc + 1.0f) + sh;
                v2u o; o.x = pk2(v.x, v.y); o.y = pk2(v.z, v.w);
                *(v2u*)(A + (size_t)row * D + c) = o; }
        }
    }
}

__device__ __forceinline__ int scan_row(int b, int c, int i, int d) {
    const bool isc = c < 4; const int T = isc ? TC : TL, pos = (isc ? c : c - 4) * 64 + i, t = d ? T - 1 - pos : pos;
    return isc ? ML + b * TC + t : b * TL + t;
}
__device__ __forceinline__ void s5_unit(const Args& a, LAS unsigned char* lds, int tid, int lane, int wave, int l, int unit) {
    const int b = unit >> 6, g = (unit >> 1) & 31, d = unit & 1, p = lane;
    const int dg = (l * 2 + d) * 32 + g;
    const float lre = a.in[I_LAMRE][dg * 64 + p], lim = a.in[I_LAMIM][dg * 64 + p], dt = expf(a.in[I_LOGDT][dg]);
    const float mag = expf(lre * dt), ang = lim * dt;
    const float abr = mag * cosf(ang), abi = mag * sinf(ang);
    const float den = lre * lre + lim * lim;
    const float f_re = ((abr - 1.f) * lre + abi * lim) / den, f_im = (abi * lre - (abr - 1.f) * lim) / den;
    float bbr[16], bbi[16], cr[16], ci[16];
#pragma unroll
    for (int h = 0; h < 16; ++h) { const float br = a.in[I_BRE][(size_t)(dg * 64 + p) * 16 + h], bi = a.in[I_BIM][(size_t)(dg * 64 + p) * 16 + h];
        bbr[h] = f_re * br - f_im * bi; bbi[h] = f_re * bi + f_im * br;
        cr[h] = a.in[I_CRE][(size_t)(dg * 16 + h) * 64 + p]; ci[h] = a.in[I_CIM][(size_t)(dg * 16 + h) * 64 + p]; }
    float a64r = abr, a64i = abi;
#pragma unroll
    for (int q = 0; q < 6; ++q) { const float t = a64r * a64r - a64i * a64i; a64i = 2.f * a64r * a64i; a64r = t; }
    LAS float* ub = (LAS float*)(lds + wave * 4096);
    LAS float* E = (LAS float*)(lds + 32768);
    LAS float* SI = (LAS float*)(lds + 32768 + 18432);
    const bf16* P = (const bf16*)(a.ws + WS_PBUF);
    float* Y = (float*)(a.ws + WS_YS5) + (size_t)d * MA * 512;
#define S5_LOAD_U(c) do { const int row_ = scan_row(b, (c), lane, d); const v4u* up_ = (const v4u*)(P + (size_t)row_ * LDP + PC_U + g * 16); const v4u u0_ = up_[0], u1_ = up_[1]; \
        LAS f32x4* ud_ = (LAS f32x4*)(ub + lane * 16); \
        ud_[0] = (f32x4){bflo(u0_.x), bfhi(u0_.x), bflo(u0_.y), bfhi(u0_.y)}; ud_[1] = (f32x4){bflo(u0_.z), bfhi(u0_.z), bflo(u0_.w), bfhi(u0_.w)}; \
        ud_[2] = (f32x4){bflo(u1_.x), bfhi(u1_.x), bflo(u1_.y), bfhi(u1_.y)}; ud_[3] = (f32x4){bflo(u1_.z), bfhi(u1_.z), bflo(u1_.w), bfhi(u1_.w)}; \
        LDS_WAIT(); asm volatile("" ::: "memory"); } while (0)
#define S5_STEP(i) do { const LAS f32x4* us_ = (const LAS f32x4*)(ub + (i) * 16); const f32x4 q0 = us_[0], q1 = us_[1], q2 = us_[2], q3 = us_[3]; \
        const float uu[16] = {q0.x, q0.y, q0.z, q0.w, q1.x, q1.y, q1.z, q1.w, q2.x, q2.y, q2.z, q2.w, q3.x, q3.y, q3.z, q3.w}; \
        float bur = 0.f, bui = 0.f; \
        _Pragma("unroll") for (int h = 0; h < 16; ++h) { bur += bbr[h] * uu[h]; bui += bbi[h] * uu[h]; } \
        const float nr_ = abr * sr - abi * si + bur, ni_ = abr * si + abi * sr + bui; sr = nr_; si = ni_; } while (0)
    for (int c = wave; c < 36; c += 8) {
        S5_LOAD_U(c);
        float sr = 0.f, si = 0.f;
        for (int i = 0; i < 64; ++i) S5_STEP(i);
        E[(c * 64 + p) * 2] = sr; E[(c * 64 + p) * 2 + 1] = si;
        asm volatile("" ::: "memory");
    }
    __syncthreads();
    if (wave == 0) { float cr_ = 0.f, ci_ = 0.f;
        for (int c = 0; c < 36; ++c) { SI[(c * 64 + p) * 2] = cr_; SI[(c * 64 + p) * 2 + 1] = ci_; const float er = E[(c * 64 + p) * 2], ei = E[(c * 64 + p) * 2 + 1];
            const float nr_ = a64r * cr_ - a64i * ci_ + er, ni_ = a64r * ci_ + a64i * cr_ + ei; cr_ = nr_; ci_ = ni_; } }
    __syncthreads();
    for (int c = wave; c < 36; c += 8) {
        S5_LOAD_U(c);
        float sr = SI[(c * 64 + p) * 2], si = SI[(c * 64 + p) * 2 + 1];
        for (int i = 0; i < 64; ++i) {
            S5_STEP(i);
            float v[16];
#pragma unroll
            for (int h = 0; h < 16; ++h) v[h] = cr[h] * sr - ci[h] * si;
            float w8[8], w4[4], w2[2];
            { const bool up = (lane & 32) != 0;
#pragma unroll
              for (int k = 0; k < 8; ++k) { const float send = up ? v[k] : v[k + 8], keep = up ? v[k + 8] : v[k]; w8[k] = keep + __shfl_xor(send, 32); } }
            { const bool up = (lane & 16) != 0;
#pragma unroll
              for (int k = 0; k < 4; ++k) { const float send = up ? w8[k] : w8[k + 4], keep = up ? w8[k + 4] : w8[k]; w4[k] = keep + __shfl_xor(send, 16); } }
            { const bool up = (lane & 8) != 0;
#pragma unroll
              for (int k = 0; k < 2; ++k) { const float send = up ? w4[k] : w4[k + 2], keep = up ? w4[k + 2] : w4[k]; w2[k] = keep + __shfl_xor(send, 8); } }
            float y;
            { const bool up = (lane & 4) != 0; const float send = up ? w2[0] : w2[1], keep = up ? w2[1] : w2[0]; y = keep + __shfl_xor(send, 4); }
            y += __shfl_xor(y, 1); y += __shfl_xor(y, 2);
            const int row = scan_row(b, c, i, d);
            if ((lane & 3) == 0) Y[(size_t)row * 512 + g * 16 + (lane >> 2)] = y;
        }
    }
    __syncthreads();
#undef S5_LOAD_U
#undef S5_STEP
}

__device__ __forceinline__ void gdn_chain(const Args& a, LAS unsigned char* lds, int tid, int l, int chain) {
    const int b = chain / 12, h = (chain >> 1) % 6, d = chain & 1;
    LAS float* qs = (LAS float*)lds; LAS float* ks = qs + 2048; LAS float* vs = ks + 2048; LAS float* egs = vs + 2048; LAS float* bes = egs + 16; LAS int* rws = (LAS int*)(bes + 16);
    const bf16* P = (const bf16*)(a.ws + WS_PBUF); const float* Gt = (const float*)(a.ws + WS_GBUF);
    float* O = (float*)(a.ws + WS_OG) + (size_t)d * MA * 768;
    const int sii = tid >> 5, l32 = tid & 31, c4 = 4 * l32;
    float wq[3][4], wk[3][4], wv[3][4];
    { const float* cw = a.in[I_CONVW] + (size_t)l * 3 * 2304;
#pragma unroll
      for (int j = 0; j < 3; ++j)
#pragma unroll
          for (int e = 0; e < 4; ++e) { wq[j][e] = cw[j * 2304 + h * 128 + c4 + e]; wk[j][e] = cw[j * 2304 + 768 + h * 128 + c4 + e]; wv[j][e] = cw[j * 2304 + 1536 + h * 128 + c4 + e]; } }
    const float nalog = -expf(a.in[I_ALOG][(l * 2 + d) * 6 + h]), dtb = a.in[I_DTB][(l * 2 + d) * 6 + h];
    const int j = tid >> 2, r = tid & 3;
    float S[32];
#pragma unroll
    for (int i = 0; i < 32; ++i) S[i] = 0.f;
    for (int blk = 0; blk < 144; ++blk) {
        const bool isc = blk < 16; const int T = isc ? TC : TL, pos0 = (isc ? blk : blk - 16) * 16;
        {
            const int pos = pos0 + sii, t = d ? T - 1 - pos : pos, row = isc ? ML + b * TC + t : b * TL + t;
            const bf16* pr = P + (size_t)row * LDP + h * 128 + c4;
            const bool hm = t > 0, hp = t < T - 1;
            float yq[4], yk[4], yv[4];
#define GDN_CONV(dst, base, w) do { const v2u x0 = *(const v2u*)(pr + (base)); v2u xm = (v2u){0u, 0u}, xp = (v2u){0u, 0u}; if (hm) xm = *(const v2u*)(pr + (base) - LDP); if (hp) xp = *(const v2u*)(pr + (base) + LDP); \
            dst[0] = siluf(w[0][0] * bflo(xm.x) + w[1][0] * bflo(x0.x) + w[2][0] * bflo(xp.x)); dst[1] = siluf(w[0][1] * bfhi(xm.x) + w[1][1] * bfhi(x0.x) + w[2][1] * bfhi(xp.x)); \
            dst[2] = siluf(w[0][2] * bflo(xm.y) + w[1][2] * bflo(x0.y) + w[2][2] * bflo(xp.y)); dst[3] = siluf(w[0][3] * bfhi(xm.y) + w[1][3] * bfhi(x0.y) + w[2][3] * bfhi(xp.y)); } while (0)
            GDN_CONV(yq, PC_GQ, wq); GDN_CONV(yk, PC_GK, wk); GDN_CONV(yv, PC_GV, wv);
#undef GDN_CONV
            float sq = yq[0] * yq[0] + yq[1] * yq[1] + yq[2] * yq[2] + yq[3] * yq[3], sk = yk[0] * yk[0] + yk[1] * yk[1] + yk[2] * yk[2] + yk[3] * yk[3];
#pragma unroll
            for (int o = 1; o < 32; o <<= 1) { sq += __shfl_xor(sq, o); sk += __shfl_xor(sk, o); }
            const float rq = (1.0f / sqrtf(sq + EPS)) * 0.08838834764831845f, rk = 1.0f / sqrtf(sk + EPS);
            *(LAS f32x4*)(qs + sii * 128 + c4) = (f32x4){yq[0] * rq, yq[1] * rq, yq[2] * rq, yq[3] * rq};
            *(LAS f32x4*)(ks + sii * 128 + c4) = (f32x4){yk[0] * rk, yk[1] * rk, yk[2] * rk, yk[3] * rk};
            *(LAS f32x4*)(vs + sii * 128 + c4) = (f32x4){yv[0], yv[1], yv[2], yv[3]};
            if (l32 == 0) { const float av = Gt[(size_t)row * 128 + GC_A + d * 6 + h], bv = Gt[(size_t)row * 128 + GC_B + d * 6 + h];
                egs[sii] = expf(nalog * softplusf(av + dtb)); bes[sii] = sigm(bv); rws[sii] = row; }
        }
        __syncthreads();
        for (int ii = 0; ii < 16; ++ii) {
            const float eg = egs[ii], be = bes[ii]; const int row = rws[ii];
            float kk[32];
#pragma unroll
            for (int i = 0; i < 8; ++i) { const f32x4 t4 = *(const LAS f32x4*)(ks + ii * 128 + 32 * r + 4 * i); kk[4 * i] = t4.x; kk[4 * i + 1] = t4.y; kk[4 * i + 2] = t4.z; kk[4 * i + 3] = t4.w; }
            float p0 = 0.f, p1 = 0.f, p2 = 0.f, p3 = 0.f;
#pragma unroll
            for (int i = 0; i < 8; ++i) { p0 += S[4 * i] * kk[4 * i]; p1 += S[4 * i + 1] * kk[4 * i + 1]; p2 += S[4 * i + 2] * kk[4 * i + 2]; p3 += S[4 * i + 3] * kk[4 * i + 3]; }
            float kS = (p0 + p1) + (p2 + p3); kS += __shfl_xor(kS, 1); kS += __shfl_xor(kS, 2);
            const float vn = be * (vs[ii * 128 + j] - eg * kS);
            float o0 = 0.f, o1 = 0.f, o2 = 0.f, o3 = 0.f;
#pragma unroll
            for (int i = 0; i < 8; ++i) { const f32x4 q4 = *(const LAS f32x4*)(qs + ii * 128 + 32 * r + 4 * i);
                S[4 * i] = eg * S[4 * i] + kk[4 * i] * vn; S[4 * i + 1] = eg * S[4 * i + 1] + kk[4 * i + 1] * vn; S[4 * i + 2] = eg * S[4 * i + 2] + kk[4 * i + 2] * vn; S[4 * i + 3] = eg * S[4 * i + 3] + kk[4 * i + 3] * vn;
                o0 += S[4 * i] * q4.x; o1 += S[4 * i + 1] * q4.y; o2 += S[4 * i + 2] * q4.z; o3 += S[4 * i + 3] * q4.w; }
            float ov = (o0 + o1) + (o2 + o3); ov += __shfl_xor(ov, 1); ov += __shfl_xor(ov, 2);
            if (r == 0) O[(size_t)row * 768 + h * 128 + j] = ov;
        }
        __syncthreads();
    }
}

__device__ __forceinline__ void mlstm_chain(const Args& a, LAS unsigned char* lds, int tid, int l, int chain) {
    const int b = chain / 12, h = (chain >> 1) % 6, d = chain & 1;
    LAS float* qs = (LAS float*)lds; LAS float* ks = qs + 1024; LAS float* vs = ks + 1024; LAS float* igs = vs + 2048; LAS float* lfs = igs + 16; LAS int* rws = (LAS int*)(lfs + 16);
    const bf16* P = (const bf16*)(a.ws + WS_PBUF); const float* Gt = (const float*)(a.ws + WS_GBUF);
    float* H = (float*)(a.ws + WS_HM) + (size_t)d * MA * 768;
    const int sii = tid >> 5, l32 = tid & 31;
    const float ib = a.in[I_IB][(l * 2 + d) * 6 + h], fb = a.in[I_FB][(l * 2 + d) * 6 + h];
    const int j = tid >> 2, r = tid & 3;
    float Cs[16], ns[16], m = 0.f;
#pragma unroll
    for (int i = 0; i < 16; ++i) { Cs[i] = 0.f; ns[i] = 0.f; }
    for (int blk = 0; blk < 144; ++blk) {
        const bool isc = blk < 16; const int pos0 = (isc ? blk : blk - 16) * 16;
        {
            const int pos = pos0 + sii; int row;
            if (isc) { const int t = d ? TC - 1 - pos : pos; row = ML + b * TC + t; }
            else { const int p = d ? TL - 1 - pos : pos; const int t = (p & 31) * 64 + (p >> 5); row = b * TL + t; }
            const bf16* pr = P + (size_t)row * LDP;
            const unsigned q2 = *(const unsigned*)(pr + PC_MQ + h * 64 + 2 * l32), k2 = *(const unsigned*)(pr + PC_MK + h * 64 + 2 * l32);
            const v2u v4 = *(const v2u*)(pr + PC_MV + h * 128 + 4 * l32);
            *(LAS f32x2*)(qs + sii * 64 + 2 * l32) = (f32x2){bflo(q2) * 0.125f, bfhi(q2) * 0.125f};
            *(LAS f32x2*)(ks + sii * 64 + 2 * l32) = (f32x2){bflo(k2), bfhi(k2)};
            *(LAS f32x4*)(vs + sii * 128 + 4 * l32) = (f32x4){bflo(v4.x), bfhi(v4.x), bflo(v4.y), bfhi(v4.y)};
            if (l32 == 0) { igs[sii] = Gt[(size_t)row * 128 + GC_I + d * 6 + h] + ib; lfs[sii] = logsigmoidf(Gt[(size_t)row * 128 + GC_F + d * 6 + h] + fb); rws[sii] = row; }
        }
        __syncthreads();
        for (int ii = 0; ii < 16; ++ii) {
            const float ig = igs[ii], lf = lfs[ii]; const int row = rws[ii];
            const float mn = fmaxf(lf + m, ig), fp = expf(lf + m - mn), ip = expf(ig - mn); m = mn;
            const float vj = vs[ii * 128 + j] * ip;
            float num = 0.f, den = 0.f;
#pragma unroll
            for (int i = 0; i < 4; ++i) { const f32x4 k4 = *(const LAS f32x4*)(ks + ii * 64 + 16 * r + 4 * i), q4 = *(const LAS f32x4*)(qs + ii * 64 + 16 * r + 4 * i);
                Cs[4 * i] = fp * Cs[4 * i] + k4.x * vj; Cs[4 * i + 1] = fp * Cs[4 * i + 1] + k4.y * vj; Cs[4 * i + 2] = fp * Cs[4 * i + 2] + k4.z * vj; Cs[4 * i + 3] = fp * Cs[4 * i + 3] + k4.w * vj;
                ns[4 * i] = fp * ns[4 * i] + ip * k4.x; ns[4 * i + 1] = fp * ns[4 * i + 1] + ip * k4.y; ns[4 * i + 2] = fp * ns[4 * i + 2] + ip * k4.z; ns[4 * i + 3] = fp * ns[4 * i + 3] + ip * k4.w;
                num += (Cs[4 * i] * q4.x + Cs[4 * i + 1] * q4.y) + (Cs[4 * i + 2] * q4.z + Cs[4 * i + 3] * q4.w);
                den += (ns[4 * i] * q4.x + ns[4 * i + 1] * q4.y) + (ns[4 * i + 2] * q4.z + ns[4 * i + 3] * q4.w); }
            num += __shfl_xor(num, 1); num += __shfl_xor(num, 2); den += __shfl_xor(den, 1); den += __shfl_xor(den, 2);
            const float hv = num / fmaxf(fabsf(den), expf(-m));
            if (r == 0) H[(size_t)row * 768 + h * 128 + j] = hv;
        }
        __syncthreads();
    }
}

__device__ __forceinline__ void finalize_rows(const Args& a, int gw, int NGW, int lane, int nrows, int l) {
    const bf16* P = (const bf16*)(a.ws + WS_PBUF);
    const float* Y0 = (const float*)(a.ws + WS_YS5); const float* Y1 = Y0 + (size_t)MA * 512;
    const float* O0 = (const float*)(a.ws + WS_OG); const float* O1 = O0 + (size_t)MA * 768;
    const float* H0 = (const float*)(a.ws + WS_HM); const float* H1 = H0 + (size_t)MA * 768;
    bf16* MIX = (bf16*)(a.ws + WS_MIX); bf16* Y5 = (bf16*)(a.ws + WS_Y5);
    const float* s5d = a.in[I_S5D] + l * 512; const float* gnorm = a.in[I_GNORM] + l * 128; const float* mnorm = a.in[I_MNORM] + l * 128;
    for (int row = gw; row < nrows; row += NGW) {
        {
            const int c0 = 8 * lane;
            const f32x4 a0 = *(const f32x4*)(Y0 + (size_t)row * 512 + c0), a1 = *(const f32x4*)(Y0 + (size_t)row * 512 + c0 + 4);
            const f32x4 b0 = *(const f32x4*)(Y1 + (size_t)row * 512 + c0), b1 = *(const f32x4*)(Y1 + (size_t)row * 512 + c0 + 4);
            const f32x4 d0 = *(const f32x4*)(s5d + c0), d1 = *(const f32x4*)(s5d + c0 + 4);
            const v4u uu = *(const v4u*)(P + (size_t)row * LDP + PC_U + c0);
            const f32x4 u0 = (f32x4){bflo(uu.x), bfhi(uu.x), bflo(uu.y), bfhi(uu.y)}, u1 = (f32x4){bflo(uu.z), bfhi(uu.z), bflo(uu.w), bfhi(uu.w)};
            const f32x4 y0 = a0 + b0 + d0 * u0, y1 = a1 + b1 + d1 * u1;
            v4u o; o.x = pk2(gelu_tanh(y0.x), gelu_tanh(y0.y)); o.y = pk2(gelu_tanh(y0.z), gelu_tanh(y0.w)); o.z = pk2(gelu_tanh(y1.x), gelu_tanh(y1.y)); o.w = pk2(gelu_tanh(y1.z), gelu_tanh(y1.w));
            *(v4u*)(Y5 + (size_t)row * 512 + c0) = o;
        }
#pragma unroll 1
        for (int hh = 0; hh < 6; ++hh) {
            const int c = hh * 128 + 2 * lane;
            const f32x2 of = *(const f32x2*)(O0 + (size_t)row * 768 + c), ob = *(const f32x2*)(O1 + (size_t)row * 768 + c);
            const float ox = of.x + ob.x, oy = of.y + ob.y;
            const float sc = 1.0f / sqrtf(wave_sum(ox * ox + oy * oy) * (1.0f / 128.f) + EPS);
            const f32x2 gn = *(const f32x2*)(gnorm + 2 * lane);
            const unsigned z2 = *(const unsigned*)(P + (size_t)row * LDP + PC_GZ + c);
            *(unsigned*)(MIX + (size_t)row * D + 512 + c) = pk2(ox * sc * gn.x * siluf(bflo(z2)), oy * sc * gn.y * siluf(bfhi(z2)));
        }
#pragma unroll 1
        for (int hh = 0; hh < 6; ++hh) {
            const int c = hh * 128 + 2 * lane;
            const f32x2 hf = *(const f32x2*)(H0 + (size_t)row * 768 + c), hb = *(const f32x2*)(H1 + (size_t)row * 768 + c);
            const float hx = hf.x + hb.x, hy = hf.y + hb.y;
            const float sc = 1.0f / sqrtf(wave_sum(hx * hx + hy * hy) * (1.0f / 128.f) + EPS);
            const f32x2 gn = *(const f32x2*)(mnorm + 2 * lane);
            const unsigned o2 = *(const unsigned*)(P + (size_t)row * LDP + PC_MO + c);
            *(unsigned*)(MIX + (size_t)row * D + 1280 + c) = pk2(hx * sc * gn.x * sigm(bflo(o2)), hy * sc * gn.y * sigm(bfhi(o2)));
        }
    }
}

constexpr int N_PHASES = 20;
__global__ void __launch_bounds__(NWAVES * 64, 2) fwd_kernel(Args args) {
    extern __shared__ __attribute__((aligned(16))) unsigned char lds_raw[];
    LAS unsigned char* lds = (LAS unsigned char*)lds_raw;
    const int G = gridDim.x, bid = blockIdx.x, NGW = G * NWAVES;
    for (int u = threadIdx.x; u < (LDS_BYTES - LDSCTL_OFF) / 4; u += NWAVES * 64) ((LAS unsigned*)(lds + LDSCTL_OFF))[u] = 0u;
    __syncthreads();
    volatile LAS unsigned* MISC = (volatile LAS unsigned*)(lds + MISC_OFF);
    XcdBarrier bar; bar.bar = (unsigned*)(args.ws + WS_CTL) + CW_BAR; bar.x = 0; bar.st = nullptr;
#if !MK_PER_PHASE
    bar = xcd_barrier_post((unsigned*)(args.ws + WS_CTL) + CW_BAR, MISC + 8);
#endif
    const int lo = args.ph_lo, hi = args.ph_hi;
#define IN(k) (lo <= (k) && (k) < hi)
#define PH_IDS() int tid = threadIdx.x; asm volatile("" : "+v"(tid)); const int lane = tid & 63, wave = __builtin_amdgcn_readfirstlane(tid >> 6), gw = bid * NWAVES + wave; (void)lane; (void)gw
#define SEAM(k) do { if (IN(k) && IN((k) + 1)) xcd_barrier(bar); } while (0)

    if (IN(0)) { PH_IDS(); p0_prologue(args, lds, tid, lane, wave, bid, G); }
    SEAM(0);
    if (IN(1)) { PH_IDS(); rowpass<true, false, false, false, true>(args, gw, NGW, lane, MA, 0, 0, nullptr, 0, args.in[I_NMPRE], 0, 1); }
    SEAM(1);
#pragma unroll 1
    for (int l = 0; l < DEPTH; ++l) {
        const int pb = 2 + 9 * l;
        unsigned char* wl = args.ws + WS_W + (size_t)l * W_LAYER;
        const int Mrows = (l == DEPTH - 1) ? ML : MA;
        if (IN(pb + 0)) {
            pg8::Gemm g{(const pg8::bf16_t*)(args.ws + WS_ABUF), (const pg8::bf16_t*)wl, MA, N1, D}; pg8::StaticOrder S; S.init(MA, N1, G, bid);
            pg8::EpiProj E{(pg8::bf16_t*)(args.ws + WS_PBUF), LDP, (float*)(args.ws + WS_GBUF), GATE_TILE};
            pg8::gemm_phase<pg8::EpiProj, pg8::StaticOrder, true, true>(lds, g, S, E);
        }
        SEAM(pb + 0);
        if (IN(pb + 1)) {
            PH_IDS();
            if (bid < 48) gdn_chain(args, lds, tid, l, bid);
            else if (bid < 96) mlstm_chain(args, lds, tid, l, bid - 48);
            else { for (int u = bid - 96; u < 256; u += G - 96) s5_unit(args, lds, tid, lane, wave, l, u); }
        }
        SEAM(pb + 1);
        if (IN(pb + 2)) { PH_IDS(); finalize_rows(args, gw, NGW, lane, Mrows, l); }
        SEAM(pb + 2);
        if (IN(pb + 3)) {
            pg8::Gemm g{(const pg8::bf16_t*)(args.ws + WS_Y5), (const pg8::bf16_t*)(wl + WGLU_OFF), Mrows, 512, 512}; pg8::StaticOrder S; S.init(Mrows, 512, G, bid);
            pg8::EpiGlu E{(const pg8::bf16_t*)(args.ws + WS_Y5), 512, (pg8::bf16_t*)(args.ws + WS_MIX), D, args.in[I_GLUB] + l * 512};
            pg8::gemm_phase<pg8::EpiGlu, pg8::StaticOrder, true, true>(lds, g, S, E);
        }
        SEAM(pb + 3);
        if (IN(pb + 4)) {
            pg8::Gemm g{(const pg8::bf16_t*)(args.ws + WS_MIX), (const pg8::bf16_t*)(wl + WO_OFF), Mrows, D, D}; pg8::StaticOrder S; S.init(Mrows, D, G, bid);
            pg8::EpiF32 E{(float*)(args.ws + WS_R), D};
            pg8::gemm_phase<pg8::EpiF32, pg8::StaticOrder, true, true>(lds, g, S, E);
        }
        SEAM(pb + 4);
        if (IN(pb + 5)) {
            PH_IDS();
            if (l == 0) rowpass<true, true, true, false, true>(args, gw, NGW, lane, Mrows, l, 2, args.in[I_NMPOST] + l * D, l, args.in[I_NFPRE] + l * D, 3, 4);
            else rowpass<false, true, true, false, true>(args, gw, NGW, lane, Mrows, l, 2, args.in[I_NMPOST] + l * D, l, args.in[I_NFPRE] + l * D, 3, 4);
        }
        SEAM(pb + 5);
        if (IN(pb + 6)) {
            pg8::Gemm g{(const pg8::bf16_t*)(args.ws + WS_ABUF), (const pg8::bf16_t*)(wl + WGU_OFF), Mrows, 2 * FF, D}; pg8::StaticOrder S; S.init(Mrows, 2 * FF, G, bid);
            pg8::EpiSwiGLU E{(pg8::bf16_t*)(args.ws + WS_PBUF), FF};
            pg8::gemm_phase<pg8::EpiSwiGLU, pg8::StaticOrder, true, true>(lds, g, S, E);
        }
        SEAM(pb + 6);
        if (IN(pb + 7)) {
            pg8::Gemm g{(const pg8::bf16_t*)(args.ws + WS_PBUF), (const pg8::bf16_t*)(wl + WD_OFF), Mrows, D, FF}; pg8::StaticOrder S; S.init(Mrows, D, G, bid);
            pg8::EpiF32 E{(float*)(args.ws + WS_R), D};
            pg8::gemm_phase<pg8::EpiF32, pg8::StaticOrder, true, true>(lds, g, S, E);
        }
        SEAM(pb + 7);
        if (IN(pb + 8)) {
            PH_IDS();
            if (l < DEPTH - 1) rowpass<false, true, true, false, true>(args, gw, NGW, lane, Mrows, l, 5, args.in[I_NFPOST] + l * D, l + 1, args.in[I_NMPRE] + (l + 1) * D, 0, 1);
            else rowpass<false, true, false, true, false>(args, gw, NGW, lane, Mrows, l, 5, args.in[I_NFPOST] + l * D, 0, nullptr, 0, 0);
        }
        SEAM(pb + 8);
    }
#undef IN
#undef SEAM
}

extern "C" void kernel_launch(void* const* d_in, const int* in_sizes, int n_in, void* d_out, int out_size, void* d_ws, size_t ws_size, hipStream_t stream) {
    static int grid = 0;
    if (grid == 0) {
        if (n_in != N_IN || in_sizes[0] != ML * D || out_size != ML * D || ws_size < WS_END) {
            fprintf(stderr, "kernel_launch: unexpected shapes (n_in %d, in0 %d, out %d, ws %zu, need %zu); nothing launched\n", n_in, n_in > 0 ? in_sizes[0] : -1, out_size, ws_size, (size_t)WS_END); grid = -1; return; }
        int dev = 0, cus = 0;
        if (hipGetDevice(&dev) != hipSuccess || hipDeviceGetAttribute(&cus, hipDeviceAttributeMultiprocessorCount, dev) != hipSuccess) { grid = -1; return; }
        if (hipFuncSetAttribute((const void*)fwd_kernel, hipFuncAttributeMaxDynamicSharedMemorySize, LDS_BYTES) != hipSuccess) { fprintf(stderr, "kernel_launch: hipFuncSetAttribute failed\n"); grid = -1; return; }
        int per_cu = 0;
        if (hipOccupancyMaxActiveBlocksPerMultiprocessor(&per_cu, (const void*)fwd_kernel, NWAVES * 64, LDS_BYTES) != hipSuccess || per_cu < 1)
            fprintf(stderr, "kernel_launch: occupancy query reports %d workgroups per CU\n", per_cu);
        (void)hipGetLastError();
        grid = cus;
        if (grid != 256) fprintf(stderr, "kernel_launch: %d CUs (built for 256)\n", grid);
    }
    if (grid < 0) return;
    (void)hipMemsetAsync((char*)d_ws + WS_CTL, 0, CTL_ZERO_BYTES, stream);
    Args a{};
    for (int i = 0; i < N_IN; ++i) a.in[i] = (const float*)d_in[i];
    a.out = (float*)d_out; a.ws = (unsigned char*)d_ws;
#if MK_PER_PHASE
    for (int ph = 0; ph < N_PHASES; ++ph) { a.ph_lo = ph; a.ph_hi = ph + 1; a.li = ph; hipLaunchKernelGGL(fwd_kernel, dim3(grid), dim3(NWAVES * 64), LDS_BYTES, stream, a); }
#else
    a.ph_lo = 0; a.ph_hi = N_PHASES; a.li = 0;
    hipLaunchKernelGGL(fwd_kernel, dim3(grid), dim3(NWAVES * 64), LDS_BYTES, stream, a);
#endif
}
```

```cpp
#include <hip/hip_runtime.h>
#include <cstdio>
#include <cstdint>
namespace pg8 {
#define PG8_LAS __attribute__((address_space(3)))
typedef unsigned short bf16_t;
typedef short bf16x8 __attribute__((ext_vector_type(8)));
typedef float f32x4 __attribute__((ext_vector_type(4)));
typedef unsigned u32x4 __attribute__((ext_vector_type(4)));
constexpr int BM = 256, BK = 64, HALF = 128, HTB = HALF * BK * 2  , STAGE_BYTES = 8 * HTB, NXCD = 8, WGM = 8;

__host__ __device__ __forceinline__ int lds_byte(int r, int c) { const int st = (r >> 4) * 2 + (c >> 5), rr = r & 15, cc = c & 31, ob = rr * 64 + cc * 2; return st * 1024 + (ob ^ (((ob >> 9) & 1) << 5)); }
__host__ __device__ __forceinline__ void stage_rc(int b, int& R, int& C) { const int st = b / 1024, sb = b % 1024, swz = sb ^ (((sb >> 9) & 1) << 5); R = (st >> 1) * 16 + swz / 64; C = (st & 1) * 32 + (swz % 64) / 2; }
__host__ __device__ __forceinline__ int perm32(int rho) { const int n = rho >> 4, i = rho & 15; return 8 * (i >> 2) + 4 * n + (i & 3); }

struct Unit { int pm, pn; };
struct Gemm { const bf16_t* A; const bf16_t* Bt; int M, N, K; };

struct StaticOrder {
    int nM, nN, nwg, G, c;
    __host__ __device__ void init(int M, int N, int G_, int c_) { nM = M / BM; nN = N / BM; nwg = nM * nN; G = G_; c = c_; }
    __host__ __device__ bool next(int i, Unit& u) const {
        const long L = (long)i * G + c; if (L >= nwg) return false;
        int wgid = (int)L; { const int q = nwg / NXCD, r = nwg % NXCD, xcd = wgid % NXCD, off = wgid / NXCD; wgid = (xcd < r ? xcd * (q + 1) : r * (q + 1) + (xcd - r) * q) + off; }
        const int nig = WGM * nN, gid = wgid / nig, fm = gid * WGM, gsz = (nM - fm) < WGM ? (nM - fm) : WGM;
        u.pm = fm + ((wgid % nig) % gsz); u.pn = (wgid % nig) / gsz; return true;
    }
    __device__ __forceinline__ void a_ready(const Unit&) const {}
    __device__ __forceinline__ void done(const Unit&) const {}
};

__device__ __forceinline__ unsigned cvt_pk_bf16(float lo, float hi) { unsigned r; asm volatile("v_cvt_pk_bf16_f32 %0, %1, %2" : "=v"(r) : "v"(lo), "v"(hi)); return r; }
__device__ __forceinline__ float bf_lo(unsigned w) { return __uint_as_float(w << 16); }
__device__ __forceinline__ float bf_hi(unsigned w) { return __uint_as_float(w & 0xffff0000u); }
__device__ __forceinline__ float sigmoidf_(float x) { return 1.0f / (1.0f + __expf(-x)); }

struct EpiF32 {
    static constexpr bool PERM = false, AFTER_DRAIN = false;
    float* C; int ldc;
    __device__ __forceinline__ void operator()(const f32x4 (&acc)[2][2][4][2], const Unit& u, int wr, int wc, int fr, int fq) const {
        const int row0 = u.pm * BM + wr * 64 + fr, col0 = u.pn * BM + wc * 32 + 4 * fq;
#pragma unroll
        for (int ai = 0; ai < 2; ++ai)
#pragma unroll
            for (int m = 0; m < 4; ++m) { float* rowp = C + (size_t)(row0 + ai * HALF + m * 16) * ldc + col0;
#pragma unroll
                for (int bj = 0; bj < 2; ++bj)
#pragma unroll
                    for (int n = 0; n < 2; ++n) *(f32x4*)(rowp + bj * HALF + n * 16) = acc[ai][bj][m][n]; }
    }
};
struct EpiProj {
    static constexpr bool PERM = true, AFTER_DRAIN = false;
    bf16_t* P; int ldp; float* G; int gate_tile;
    __device__ __forceinline__ void operator()(const f32x4 (&acc)[2][2][4][2], const Unit& u, int wr, int wc, int fr, int fq) const {
        const int row0 = u.pm * BM + wr * 64 + fr;
        if (u.pn != gate_tile) {
            const int col0 = u.pn * BM + wc * 32 + 8 * fq;
#pragma unroll
            for (int ai = 0; ai < 2; ++ai)
#pragma unroll
                for (int m = 0; m < 4; ++m) { bf16_t* rowp = P + (size_t)(row0 + ai * HALF + m * 16) * ldp + col0;
#pragma unroll
                    for (int bj = 0; bj < 2; ++bj) { const f32x4 v0 = acc[ai][bj][m][0], v1 = acc[ai][bj][m][1];
                        u32x4 w; w.x = cvt_pk_bf16(v0[0], v0[1]); w.y = cvt_pk_bf16(v0[2], v0[3]); w.z = cvt_pk_bf16(v1[0], v1[1]); w.w = cvt_pk_bf16(v1[2], v1[3]);
                        *(u32x4*)(rowp + bj * HALF) = w; } }
        } else {
            const int col0 = wc * 32 + 8 * fq;
#pragma unroll
            for (int ai = 0; ai < 2; ++ai)
#pragma unroll
                for (int m = 0; m < 4; ++m) { float* rowp = G + (size_t)(row0 + ai * HALF + m * 16) * 128 + col0;
                    *(f32x4*)(rowp) = acc[ai][0][m][0]; *(f32x4*)(rowp + 4) = acc[ai][0][m][1]; }
        }
    }
};
struct EpiSwiGLU {
    static constexpr bool PERM = true, AFTER_DRAIN = false;
    bf16_t* O; int ldc;
    __device__ __forceinline__ void operator()(const f32x4 (&acc)[2][2][4][2], const Unit& u, int wr, int wc, int fr, int fq) const {
        const int row0 = u.pm * BM + wr * 64 + fr, col0 = u.pn * HALF + wc * 32 + 8 * fq;
#pragma unroll
        for (int ai = 0; ai < 2; ++ai)
#pragma unroll
            for (int m = 0; m < 4; ++m) { bf16_t* rowp = O + (size_t)(row0 + ai * HALF + m * 16) * ldc + col0;
                float r[8];
#pragma unroll
                for (int n = 0; n < 2; ++n)
#pragma unroll
                    for (int j = 0; j < 4; ++j) { const float g = acc[ai][0][m][n][j], up = acc[ai][1][m][n][j]; r[n * 4 + j] = g * sigmoidf_(g) * up; }
                u32x4 w; w.x = cvt_pk_bf16(r[0], r[1]); w.y = cvt_pk_bf16(r[2], r[3]); w.z = cvt_pk_bf16(r[4], r[5]); w.w = cvt_pk_bf16(r[6], r[7]);
                *(u32x4*)rowp = w; }
    }
};
struct EpiGlu {
    static constexpr bool PERM = true, AFTER_DRAIN = false;
    const bf16_t* Y; int ldy; bf16_t* O; int ldo; const float* bias;
    __device__ __forceinline__ void operator()(const f32x4 (&acc)[2][2][4][2], const Unit& u, int wr, int wc, int fr, int fq) const {
        const int row0 = u.pm * BM + wr * 64 + fr, col0 = u.pn * BM + wc * 32 + 8 * fq;
        f32x4 bv[2][2];
#pragma unroll
        for (int bj = 0; bj < 2; ++bj)
#pragma unroll
            for (int n = 0; n < 2; ++n) bv[bj][n] = *(const f32x4*)(bias + col0 + bj * HALF + 4 * n);
#pragma unroll
        for (int ai = 0; ai < 2; ++ai)
#pragma unroll
            for (int m = 0; m < 4; ++m) { const size_t row = (size_t)(row0 + ai * HALF + m * 16);
#pragma unroll
                for (int bj = 0; bj < 2; ++bj) {
                    const u32x4 yv = *(const u32x4*)(Y + row * ldy + col0 + bj * HALF);
                    const f32x4 v0 = acc[ai][bj][m][0] + bv[bj][0], v1 = acc[ai][bj][m][1] + bv[bj][1];
                    u32x4 w;
                    w.x = cvt_pk_bf16(bf_lo(yv.x) * sigmoidf_(v0[0]), bf_hi(yv.x) * sigmoidf_(v0[1]));
                    w.y = cvt_pk_bf16(bf_lo(yv.y) * sigmoidf_(v0[2]), bf_hi(yv.y) * sigmoidf_(v0[3]));
                    w.z = cvt_pk_bf16(bf_lo(yv.z) * sigmoidf_(v1[0]), bf_hi(yv.z) * sigmoidf_(v1[1]));
                    w.w = cvt_pk_bf16(bf_lo(yv.w) * sigmoidf_(v1[2]), bf_hi(yv.w) * sigmoidf_(v1[3]));
                    *(u32x4*)(O + row * ldo + col0 + bj * HALF) = w; } }
    }
};

template <class Epi, class Sched, bool ALIGN_EPI = false, bool SP2 = false>
__device__ __forceinline__ void gemm_phase(PG8_LAS unsigned char* lds, const Gemm g, const Sched& S, const Epi& E) {
    int tid_ = threadIdx.x; asm volatile("" : "+v"(tid_));
    const int tid = tid_, wid = __builtin_amdgcn_readfirstlane(tid >> 6), lane = tid & 63, wr = wid >> 2, wc = wid & 3, fr = lane & 15, fq = lane >> 4;
    const int K = g.K, nt = K / BK;
    unsigned voffA[2], voffB[2];
#pragma unroll
    for (int i = 0; i < 2; ++i) { int R, C; stage_rc(tid * 16 + i * 8192, R, C); const int Rb = Epi::PERM ? ((R & ~31) + perm32(R & 31)) : R;
        voffA[i] = (unsigned)(R * K + C) * 2u; voffB[i] = (unsigned)(Rb * K + C) * 2u; }
    const size_t kstep = (size_t)(BK * 2);
    const size_t hstep = (size_t)HALF * K * 2;
    const size_t tstep = 2 * hstep;
    const unsigned ldsw = (unsigned)wid * 1024u;
    const int aoff = lds_byte(wr * 64 + fr, fq * 8), boff = lds_byte(wc * 32 + fr, fq * 8);
#define PG8_SA(b, h) (((b) * 2 + (h)) * HTB)
#define PG8_SB(b, h) ((4 + (b) * 2 + (h)) * HTB)
#define PG8_STAGE(bufoff, gbase, voff) do { _Pragma("unroll") for (int _i = 0; _i < 2; ++_i) \
        __builtin_amdgcn_global_load_lds((const unsigned*)((const char*)(gbase) + (voff)[_i]), (PG8_LAS unsigned*)(lds + (bufoff) + ldsw + _i * 8192), 16, 0, 0); } while (0)
#define PG8_LDA(dst, b, h) do { _Pragma("unroll") for (int m = 0; m < 4; ++m) _Pragma("unroll") for (int k = 0; k < 2; ++k) dst[m][k] = *(const PG8_LAS bf16x8*)(lds + PG8_SA(b, h) + aoff + m * 2048 + k * 1024); } while (0)
#define PG8_LDB(dst, b, h) do { _Pragma("unroll") for (int n = 0; n < 2; ++n) _Pragma("unroll") for (int k = 0; k < 2; ++k) dst[n][k] = *(const PG8_LAS bf16x8*)(lds + PG8_SB(b, h) + boff + n * 2048 + k * 1024); } while (0)
#define PG8_MMA(ai, bj, At, Bt) do { __builtin_amdgcn_s_setprio(1); _Pragma("unroll") for (int m = 0; m < 4; ++m) _Pragma("unroll") for (int n = 0; n < 2; ++n) _Pragma("unroll") for (int k = 0; k < 2; ++k) \
        acc[ai][bj][m][n] = __builtin_amdgcn_mfma_f32_16x16x32_bf16(Bt[n][k], At[m][k], acc[ai][bj][m][n], 0, 0, 0); __builtin_amdgcn_s_setprio(0); } while (0)
#define PG8_WAIT_V(n) asm volatile("s_waitcnt vmcnt(" #n ")" ::: "memory")
#define PG8_WAIT_L(n) asm volatile("s_waitcnt lgkmcnt(" #n ")" ::: "memory")
#define PG8_BAR __builtin_amdgcn_s_barrier()
#define PG8_SCHED __builtin_amdgcn_sched_barrier(0)
    Unit cur, nxt; int ui = 0;
    if (!S.next(0, cur)) return;
    f32x4 acc[2][2][4][2];
#pragma unroll
    for (int a = 0; a < 2; ++a)
#pragma unroll
        for (int b = 0; b < 2; ++b)
#pragma unroll
            for (int m = 0; m < 4; ++m)
#pragma unroll
                for (int n = 0; n < 2; ++n) acc[a][b][m][n] = (f32x4){0.f, 0.f, 0.f, 0.f};
    bf16x8 At[4][2], B0[2][2], B1[2][2];
    const char* cA = (const char*)g.A + (size_t)cur.pm * tstep; const char* cB = (const char*)g.Bt + (size_t)cur.pn * tstep;
    S.a_ready(cur);
    if constexpr (SP2) {
        PG8_STAGE(PG8_SB(0, 0), cB, voffB); PG8_STAGE(PG8_SB(0, 1), cB + hstep, voffB); PG8_STAGE(PG8_SA(0, 0), cA, voffA); PG8_STAGE(PG8_SA(0, 1), cA + hstep, voffA);
        if (wr == 1) PG8_BAR;
        PG8_WAIT_V(2); PG8_BAR;
        PG8_STAGE(PG8_SB(1, 0), cB + kstep, voffB); PG8_STAGE(PG8_SA(1, 0), cA + kstep, voffA); PG8_STAGE(PG8_SB(1, 1), cB + hstep + kstep, voffB);
        PG8_WAIT_V(6); PG8_BAR;
    } else {
        PG8_STAGE(PG8_SB(0, 0), cB, voffB); PG8_STAGE(PG8_SA(0, 0), cA, voffA); PG8_STAGE(PG8_SB(0, 1), cB + hstep, voffB); PG8_STAGE(PG8_SA(0, 1), cA + hstep, voffA);
        if (wr == 1) PG8_BAR;
        PG8_WAIT_V(4); PG8_BAR;
        PG8_STAGE(PG8_SB(1, 0), cB + kstep, voffB); PG8_STAGE(PG8_SA(1, 0), cA + kstep, voffA); PG8_STAGE(PG8_SB(1, 1), cB + hstep + kstep, voffB);
        PG8_WAIT_V(6); PG8_BAR;
    }
    for (;;) {
        const bool has_next = S.next(ui + 1, nxt);
        const char* nA = has_next ? (const char*)g.A + (size_t)nxt.pm * tstep : cA; const char* nB = has_next ? (const char*)g.Bt + (size_t)nxt.pn * tstep : cB;
        for (int t = 0; t < nt; t += 2) {
            const bool last = (t == nt - 2);
            const char* a1 = cA + (size_t)(t + 1) * kstep;
            const char* a2 = last ? nA : cA + (size_t)(t + 2) * kstep; const char* b2 = last ? nB : cB + (size_t)(t + 2) * kstep;
            const char* a3 = a2 + kstep; const char* b3 = b2 + kstep;
            if (last && has_next) S.a_ready(nxt);
            if constexpr (SP2) {
            PG8_LDB(B0, 0, 0); PG8_LDB(B1, 0, 1); PG8_SCHED; PG8_LDA(At, 0, 0); PG8_STAGE(PG8_SA(1, 1), a1 + hstep, voffA);
            PG8_WAIT_V(8); PG8_WAIT_L(0); PG8_BAR; PG8_MMA(0, 0, At, B0); PG8_MMA(0, 1, At, B1); PG8_BAR; PG8_SCHED;
            PG8_LDA(At, 0, 1); PG8_STAGE(PG8_SB(0, 0), b2, voffB); PG8_STAGE(PG8_SB(0, 1), b2 + hstep, voffB); PG8_STAGE(PG8_SA(0, 0), a2, voffA);
            PG8_WAIT_V(8); PG8_WAIT_L(0); PG8_BAR; PG8_MMA(1, 0, At, B0); PG8_MMA(1, 1, At, B1); PG8_BAR; PG8_SCHED;
            PG8_LDB(B0, 1, 0); PG8_LDB(B1, 1, 1); PG8_SCHED; PG8_LDA(At, 1, 0); PG8_STAGE(PG8_SA(0, 1), a2 + hstep, voffA);
            PG8_WAIT_V(8); PG8_WAIT_L(0); PG8_BAR; PG8_MMA(0, 0, At, B0); PG8_MMA(0, 1, At, B1); PG8_BAR; PG8_SCHED;
            PG8_LDA(At, 1, 1); PG8_STAGE(PG8_SB(1, 0), b3, voffB); PG8_STAGE(PG8_SB(1, 1), b3 + hstep, voffB); PG8_STAGE(PG8_SA(1, 0), a3, voffA);
            PG8_WAIT_V(8); PG8_WAIT_L(0); PG8_BAR; PG8_MMA(1, 0, At, B0); PG8_MMA(1, 1, At, B1); PG8_BAR; PG8_SCHED;
            } else {
            PG8_LDB(B0, 0, 0); PG8_SCHED; PG8_LDA(At, 0, 0); PG8_STAGE(PG8_SA(1, 1), a1 + hstep, voffA);
            PG8_WAIT_L(8); PG8_BAR; PG8_WAIT_L(0); PG8_MMA(0, 0, At, B0); PG8_BAR; PG8_SCHED;
            PG8_LDB(B1, 0, 1); PG8_STAGE(PG8_SB(0, 0), b2, voffB);
            PG8_BAR; PG8_WAIT_L(0); PG8_MMA(0, 1, At, B1); PG8_BAR;
            PG8_LDA(At, 0, 1); PG8_STAGE(PG8_SA(0, 0), a2, voffA);
            PG8_BAR; PG8_WAIT_L(0); PG8_MMA(1, 0, At, B0); PG8_BAR; PG8_SCHED;
            PG8_STAGE(PG8_SB(0, 1), b2 + hstep, voffB);
            PG8_WAIT_V(6); PG8_BAR; PG8_MMA(1, 1, At, B1); PG8_BAR;
            PG8_LDB(B0, 1, 0); PG8_SCHED; PG8_LDA(At, 1, 0); PG8_STAGE(PG8_SA(0, 1), a2 + hstep, voffA);
            PG8_WAIT_L(8); PG8_BAR; PG8_WAIT_L(0); PG8_MMA(0, 0, At, B0); PG8_BAR; PG8_SCHED;
            PG8_LDB(B1, 1, 1); PG8_STAGE(PG8_SB(1, 0), b3, voffB);
            PG8_BAR; PG8_WAIT_L(0); PG8_MMA(0, 1, At, B1); PG8_BAR;
            PG8_LDA(At, 1, 1); PG8_STAGE(PG8_SA(1, 0), a3, voffA);
            PG8_BAR; PG8_WAIT_L(0); PG8_MMA(1, 0, At, B0); PG8_BAR; PG8_SCHED;
            PG8_STAGE(PG8_SB(1, 1), b3 + hstep, voffB);
            PG8_WAIT_V(6); PG8_BAR; PG8_MMA(1, 1, At, B1); PG8_BAR;
            }
        }
        if constexpr (ALIGN_EPI) { if (wr == 0) PG8_BAR; }
        if constexpr (!Epi::AFTER_DRAIN) { E(acc, cur, wr, wc, fr, fq); S.done(cur); }
        if (!has_next) break;
#pragma unroll
        for (int a = 0; a < 2; ++a)
#pragma unroll
            for (int b = 0; b < 2; ++b)
#pragma unroll
                for (int m = 0; m < 4; ++m)
#pragma unroll
                    for (int n = 0; n < 2; ++n) acc[a][b][m][n] = (f32x4){0.f, 0.f, 0.f, 0.f};
        cur = nxt; cA = nA; cB = nB; ++ui;
        if constexpr (ALIGN_EPI) { if (wr == 1) PG8_BAR; }
    }
    PG8_WAIT_V(0);
    if constexpr (!ALIGN_EPI) { if (wr == 0) PG8_BAR; }
    PG8_BAR;
    if constexpr (Epi::AFTER_DRAIN) { E.fused(acc, cur, wr, wc, fr, fq, lds, wid, lane); S.done(cur); }
#undef PG8_SA
#undef PG8_SB
#undef PG8_STAGE
#undef PG8_LDA
#undef PG8_LDB
#undef PG8_MMA
#undef PG8_WAIT_V
#undef PG8_WAIT_L
#undef PG8_BAR
#undef PG8_SCHED
}
}

#ifndef MK_PER_PHASE
#define MK_PER_PHASE 0
#endif
constexpr int NWAVES = 8;
constexpr int NB = 4, TL = 2048, TC = 256, D = 2048, DEPTH = 2;
constexpr int ML = NB * TL, MC = NB * TC, MA = ML + MC;
constexpr int NPROJ = 5936, N1 = 6144, LDP = 5888, GATE_TILE = 23;
constexpr int FF = 5632;
constexpr float EPS = 1e-6f;
constexpr int PC_U = 0, PC_GQ = 512, PC_GK = 1280, PC_GV = 2048, PC_GZ = 2816, PC_MQ = 3584, PC_MK = 3968, PC_MV = 4352, PC_MO = 5120;
constexpr int GC_A = 0, GC_B = 12, GC_I = 24, GC_F = 36;
enum { I_X = 0, I_C, I_CTX, I_CCTX, I_ADAW, I_ADAB, I_NMPRE, I_NMPOST, I_NFPRE, I_NFPOST, I_WIN, I_WOUT, I_LAMRE, I_LAMIM, I_LOGDT, I_BRE, I_BIM, I_CRE, I_CIM, I_S5D,
       I_GLUW, I_GLUB, I_CONVW, I_ALOG, I_DTB, I_GNORM, I_IB, I_FB, I_MNORM, I_WG, I_WU, I_WD, N_IN };

constexpr size_t MiB = 1u << 20;
constexpr size_t WS_CTL = 0, CTL_ZERO_BYTES = 64 * 1024;
constexpr size_t WS_MODS = 1 * MiB;
constexpr size_t WS_W = 2 * MiB, W_LAYER = 99 * MiB;
constexpr size_t WO_OFF = 24 * MiB, WGU_OFF = 32 * MiB, WD_OFF = 76 * MiB, WGLU_OFF = 98 * MiB;
constexpr size_t WS_XBUF = WS_W + 2 * W_LAYER;
constexpr size_t WS_ABUF = WS_XBUF + 72 * MiB;
constexpr size_t WS_PBUF = WS_ABUF + 36 * MiB;
constexpr size_t WS_GBUF = WS_PBUF + 104 * MiB;
constexpr size_t WS_YS5 = WS_GBUF + 5 * MiB;
constexpr size_t WS_OG = WS_YS5 + 36 * MiB;
constexpr size_t WS_HM = WS_OG + 54 * MiB;
constexpr size_t WS_MIX = WS_HM + 54 * MiB;
constexpr size_t WS_Y5 = WS_MIX + 36 * MiB;
constexpr size_t WS_R = WS_Y5 + 9 * MiB;
constexpr size_t WS_END = WS_R + 72 * MiB;
static_assert(WS_END <= 768 * MiB, "workspace map");
constexpr int CW_TMO = 0, CW_BAR = 4096;

constexpr int RING_BYTES = 131072, LDSCTL_OFF = RING_BYTES, MISC_OFF = LDSCTL_OFF + 320, LDS_BYTES = 147456;

#define GAS __attribute__((address_space(1)))
#define LAS __attribute__((address_space(3)))
typedef unsigned short bf16;
typedef unsigned v4u __attribute__((ext_vector_type(4)));
typedef unsigned v2u __attribute__((ext_vector_type(2)));
typedef float f32x4 __attribute__((ext_vector_type(4)));
typedef float f32x2 __attribute__((ext_vector_type(2)));
typedef GAS unsigned gu32;
#define RLX_AGENT __ATOMIC_RELAXED, __HIP_MEMORY_SCOPE_AGENT
#define LDS_WAIT() asm volatile("s_waitcnt lgkmcnt(0)" ::: "memory")
#define VM_WAIT() asm volatile("s_waitcnt vmcnt(0)" ::: "memory")
__device__ __forceinline__ unsigned f2bf(float f) { unsigned u = __builtin_bit_cast(unsigned, f); return (u + 0x7fffu + ((u >> 16) & 1u)) >> 16; }
__device__ __forceinline__ unsigned pk2(float lo, float hi) { return f2bf(lo) | (f2bf(hi) << 16); }
__device__ __forceinline__ float bflo(unsigned w) { return __uint_as_float(w << 16); }
__device__ __forceinline__ float bfhi(unsigned w) { return __uint_as_float(w & 0xffff0000u); }
__device__ __forceinline__ float sigm(float x) { return 1.0f / (1.0f + __expf(-x)); }
__device__ __forceinline__ float siluf(float x) { return x * sigm(x); }
__device__ __forceinline__ float softplusf(float x) { return x > 20.f ? x : log1pf(expf(x)); }
__device__ __forceinline__ float logsigmoidf(float x) { return fminf(x, 0.f) - log1pf(expf(-fabsf(x))); }
__device__ __forceinline__ float gelu_tanh(float x) { return 0.5f * x * (1.0f + tanhf(0.7978845608028654f * (x + 0.044715f * x * x * x))); }
__device__ __forceinline__ float wave_sum(float v) {
#pragma unroll
    for (int o = 1; o < 64; o <<= 1) v += __shfl_xor(v, o);
    return v;
}
#define XB_TMO      128
#define XB_XCNT(j)  (256  + 64 * (j))
#define XB_XSUB(j)  (1280 + 64 * (j))
#define XB_XGEN(j)  (2304 + 64 * (j))
#define XB_TOP      3328
#define XB_TOPGEN   3392
#define XCD_BAR_WORDS 3456
#define XB_SPIN_CAP (1u << 18)

__device__ __forceinline__ unsigned xb_ld(unsigned* p)              { return __hip_atomic_load(p, __ATOMIC_RELAXED, __HIP_MEMORY_SCOPE_AGENT); }
__device__ __forceinline__ unsigned xb_add(unsigned* p, unsigned v) { return __hip_atomic_fetch_add(p, v, __ATOMIC_RELAXED, __HIP_MEMORY_SCOPE_AGENT); }
__device__ __forceinline__ unsigned xb_xcc_id() { return (unsigned)__builtin_amdgcn_s_getreg((3 << 11) | 20) & 0xFu; }
#define XB_SPIN(cond, bar) do { unsigned _sp = 0; while (cond) { __builtin_amdgcn_s_sleep(1); \
    if ((++_sp & 255u) == 0u) { if (xb_ld(&(bar)[XB_TMO])) break; if (_sp > XB_SPIN_CAP) { atomicAdd(&(bar)[XB_TMO], 1u); break; } } } } while (0)

struct XcdBarrier {
    unsigned* bar; unsigned x;
    volatile LAS unsigned* st;
};

__device__ __forceinline__ XcdBarrier xcd_barrier_post(unsigned* bar, volatile LAS unsigned* st) {
    XcdBarrier b; b.bar = bar; b.x = xb_xcc_id(); b.st = st;
    if (threadIdx.x == 0) (void)xb_add(&bar[XB_XCNT(b.x)], 1u);
    return b;
}
__device__ __forceinline__ void xcd_barrier_complete(unsigned* bar, unsigned x, unsigned& nloc, unsigned& nx) {
    const unsigned G = gridDim.x * gridDim.y * gridDim.z;
    unsigned sum, cnt, mine, sp = 0u;
    for (;;) {
        sum = 0u; cnt = 0u; mine = 0u;
#pragma unroll
        for (unsigned j = 0; j < 16; ++j) { const unsigned c = xb_ld(&bar[XB_XCNT(j)]); sum += c; cnt += (c > 0u) ? 1u : 0u; mine = (j == x) ? c : mine; }
        if (sum == G) break;
        __builtin_amdgcn_s_sleep(1);
        if ((++sp & 255u) == 0u) { if (xb_ld(&bar[XB_TMO])) break; if (sp > XB_SPIN_CAP) { atomicAdd(&bar[XB_TMO], 1u); break; } }
    }
    nloc = mine > 0u ? mine : 1u; nx = cnt > 0u ? cnt : 1u;
}

__device__ __forceinline__ void xcd_barrier(const XcdBarrier& b) {
    asm volatile("s_waitcnt vmcnt(0)" ::: "memory");
    __syncthreads();
    if (threadIdx.x == 0) {
        unsigned* bar = b.bar;
        __builtin_amdgcn_s_waitcnt(0);
        unsigned nloc = b.st[0], nx = b.st[1];
        if (nloc == 0u) { xcd_barrier_complete(bar, b.x, nloc, nx); b.st[0] = nloc; b.st[1] = nx; }
        const unsigned old = xb_add(&bar[XB_XSUB(b.x)], 1u);
        const unsigned gen = old / nloc;
        if (old + 1u == (gen + 1u) * nloc) {
            __builtin_amdgcn_fence(__ATOMIC_RELEASE, "agent");
            asm volatile("s_waitcnt vmcnt(0)" ::: "memory");
            const unsigned og = xb_add(&bar[XB_TOP], 1u);
            const unsigned tg = og / nx;
            if (og + 1u == (tg + 1u) * nx) xb_add(&bar[XB_TOPGEN], 1u);
            else XB_SPIN(xb_ld(&bar[XB_TOPGEN]) == tg, bar);
            __builtin_amdgcn_fence(__ATOMIC_ACQUIRE, "agent");
            xb_add(&bar[XB_XGEN(b.x)], 1u);
            asm volatile("s_waitcnt vmcnt(0)" ::: "memory");
        } else {
            XB_SPIN(xb_ld(&bar[XB_XGEN(b.x)]) == gen, bar);
            __builtin_amdgcn_fence(__ATOMIC_ACQUIRE, "agent");
            asm volatile("s_waitcnt vmcnt(0)" ::: "memory");
        }
    }
    __syncthreads();
}

struct Args { const float* in[N_IN]; float* out; unsigned char* ws; int ph_lo, ph_hi, li, pad; };

template <int MODE> __device__ __forceinline__ int dst_row(int n) {
    if (MODE == 1) return n < 3584 ? n : (n < 3608 ? 5888 + (n - 3584) : (n < 5912 ? n - 24 : n));
    if (MODE == 2) return 256 * (n >> 7) + (n & 127);
    if (MODE == 3) return 256 * (n >> 7) + 128 + (n & 127);
    return n;
}
template <int MODE> __device__ __forceinline__ void transpose_item(const float* W, int K, int N, bf16* WT, LAS float* scr, int item, int lane) {
    const int nblk = (N + 31) / 32, kb = item / nblk, nb = item % nblk, k0 = 64 * kb, n0 = 32 * nb;
    const int nn = n0 + (lane & 31);
#pragma unroll 8
    for (int i = 0; i < 32; ++i) { const int kk = 2 * i + (lane >> 5); scr[kk * 33 + (lane & 31)] = nn < N ? W[(size_t)(k0 + kk) * N + nn] : 0.f; }
    LDS_WAIT(); asm volatile("" ::: "memory");
    const int c = lane & 7;
#pragma unroll
    for (int j = 0; j < 4; ++j) { const int nl = (lane >> 3) + 8 * j, n = n0 + nl; const LAS float* s = scr + (8 * c) * 33 + nl;
        v4u o; o.x = pk2(s[0 * 33], s[1 * 33]); o.y = pk2(s[2 * 33], s[3 * 33]); o.z = pk2(s[4 * 33], s[5 * 33]); o.w = pk2(s[6 * 33], s[7 * 33]);
        if (n < N) *(GAS v4u*)(WT + (size_t)dst_row<MODE>(n) * K + k0 + 8 * c) = o; }
    LDS_WAIT(); asm volatile("" ::: "memory");
}
__device__ __forceinline__ void p0_prologue(const Args& a, LAS unsigned char* lds, int tid, int lane, int wave, int bid, int G) {
    {
        LAS float* sc = (LAS float*)lds;
        LAS float* red = (LAS float*)(lds + 40960);
        float* mods = (float*)(a.ws + WS_MODS);
        for (int i = tid; i < 5 * D; i += NWAVES * 64) { const int r = i >> 11, k = i & 2047; const float v = r < 4 ? a.in[I_C][r * D + k] : a.in[I_CCTX][k]; sc[i] = siluf(v); }
        __syncthreads();
        for (int unit = bid; unit < 192; unit += G) {
            const int l = unit / 96, n0 = (unit % 96) * 128;
            const float* W = a.in[I_ADAW] + (size_t)l * D * (6 * D) + n0 + 2 * lane;
            float acc[5][2];
#pragma unroll
            for (int r = 0; r < 5; ++r) { acc[r][0] = 0.f; acc[r][1] = 0.f; }
            const int kbeg = wave * 256;
#pragma unroll 8
            for (int kk = 0; kk < 256; ++kk) { const int k = kbeg + kk; const f32x2 w = *(const f32x2*)(W + (size_t)k * (6 * D));
#pragma unroll
                for (int r = 0; r < 5; ++r) { const float s = sc[r * D + k]; acc[r][0] += s * w.x; acc[r][1] += s * w.y; } }
#pragma unroll
            for (int r = 0; r < 5; ++r) { red[(wave * 5 + r) * 128 + 2 * lane] = acc[r][0]; red[(wave * 5 + r) * 128 + 2 * lane + 1] = acc[r][1]; }
            __syncthreads();
            for (int o = tid; o < 640; o += NWAVES * 64) { const int r = o >> 7, c = o & 127; float s = 0.f;
#pragma unroll
                for (int w = 0; w < 8; ++w) s += red[(w * 5 + r) * 128 + c];
                mods[(size_t)(l * 5 + r) * (6 * D) + n0 + c] = s + a.in[I_ADAB][l * 6 * D + n0 + c]; }
            __syncthreads();
        }
    }
    {
        LAS float* scr = (LAS float*)(lds + 61440 + wave * 8448);
        const int gw = bid * NWAVES + wave, NGW = G * NWAVES;
        constexpr int IT_IN = 32 * 186, IT_OUT = 32 * 64, IT_G = 32 * 176, IT_D = 88 * 64, IT_GLU = 8 * 16, IT_LAYER = IT_IN + IT_OUT + 2 * IT_G + IT_D + IT_GLU;
        for (int it = gw; it < DEPTH * IT_LAYER; it += NGW) {
            const int l = it / IT_LAYER; int r = it % IT_LAYER; unsigned char* wl = a.ws + WS_W + (size_t)l * W_LAYER;
            if (r < IT_IN) { transpose_item<1>(a.in[I_WIN] + (size_t)l * D * NPROJ, D, NPROJ, (bf16*)wl, scr, r, lane); continue; } r -= IT_IN;
            if (r < IT_OUT) { transpose_item<0>(a.in[I_WOUT] + (size_t)l * D * D, D, D, (bf16*)(wl + WO_OFF), scr, r, lane); continue; } r -= IT_OUT;
            if (r < IT_G) { transpose_item<2>(a.in[I_WG] + (size_t)l * D * FF, D, FF, (bf16*)(wl + WGU_OFF), scr, r, lane); continue; } r -= IT_G;
            if (r < IT_G) { transpose_item<3>(a.in[I_WU] + (size_t)l * D * FF, D, FF, (bf16*)(wl + WGU_OFF), scr, r, lane); continue; } r -= IT_G;
            if (r < IT_D) { transpose_item<0>(a.in[I_WD] + (size_t)l * FF * D, FF, D, (bf16*)(wl + WD_OFF), scr, r, lane); continue; } r -= IT_D;
            transpose_item<0>(a.in[I_GLUW] + (size_t)l * 512 * 512, 512, 512, (bf16*)(wl + WGLU_OFF), scr, r, lane);
        }
        constexpr int ZV = (N1 - NPROJ) * D * 2 / 16;
        for (int i = bid * NWAVES * 64 + tid; i < DEPTH * ZV; i += G * NWAVES * 64) { const int l = i / ZV, r = i % ZV;
            *(GAS v4u*)(a.ws + WS_W + (size_t)l * W_LAYER + (size_t)NPROJ * D * 2 + (size_t)r * 16) = (v4u){0u, 0u, 0u, 0u}; }
    }
}

template <bool SRC_IN, bool HAS_R, bool WRITE_X, bool WRITE_OUT, bool MAKE_A>
__device__ __forceinline__ void rowpass(const Args& a, int gw, int NGW, int lane, int nrows, int l, int gate_chunk, const float* gpost, int la, const float* gpre, int sh_chunk, int sc_chunk) {
    const float* mods = (const float*)(a.ws + WS_MODS);
    float* xbuf = (float*)(a.ws + WS_XBUF);
    const float* R = (const float*)(a.ws + WS_R);
    bf16* A = (bf16*)(a.ws + WS_ABUF);
    for (int row = gw; row < nrows; row += NGW) {
        const int r5 = row < ML ? row / TL : 4;
        const float* xs = SRC_IN ? (row < ML ? a.in[I_X] + (size_t)row * D : a.in[I_CTX] + (size_t)(row - ML) * D) : xbuf + (size_t)row * D;
        f32x4 xv[8];
#pragma unroll
        for (int j = 0; j < 8; ++j) xv[j] = *(const f32x4*)(xs + 4 * lane + 256 * j);
        if (HAS_R) {
            f32x4 rv[8]; float ss = 0.f;
#pragma unroll
            for (int j = 0; j < 8; ++j) { rv[j] = *(const f32x4*)(R + (size_t)row * D + 4 * lane + 256 * j); ss += (rv[j].x * rv[j].x + rv[j].y * rv[j].y) + (rv[j].z * rv[j].z + rv[j].w * rv[j].w); }
            const float rstd = 1.0f / sqrtf(wave_sum(ss) * (1.0f / D) + EPS);
            const float* mg = mods + ((size_t)(l * 5 + r5) * 6 + gate_chunk) * D;
#pragma unroll
            for (int j = 0; j < 8; ++j) { const int c = 4 * lane + 256 * j; const f32x4 g = *(const f32x4*)(gpost + c), gt = *(const f32x4*)(mg + c);
                xv[j] = xv[j] + gt * (rv[j] * rstd * g);
                if (WRITE_X) *(f32x4*)(xbuf + (size_t)row * D + c) = xv[j];
                if (WRITE_OUT) *(f32x4*)(a.out + (size_t)row * D + c) = xv[j]; }
        }
        if (MAKE_A) {
            float ss = 0.f;
#pragma unroll
            for (int j = 0; j < 8; ++j) ss += (xv[j].x * xv[j].x + xv[j].y * xv[j].y) + (xv[j].z * xv[j].z + xv[j].w * xv[j].w);
            const float rstd = 1.0f / sqrtf(wave_sum(ss) * (1.0f / D) + EPS);
            const float* msh = mods + ((size_t)(la * 5 + r5) * 6 + sh_chunk) * D; const float* msc = mods + ((size_t)(la * 5 + r5) * 6 + sc_chunk) * D;
#pragma unroll
            for (int j = 0; j < 8; ++j) { const int c = 4 * lane + 256 * j; const f32x4 g = *(const f32x4*)(gpre + c), sh = *(const f32x4*)(msh + c), sc = *(const f32x4*)(msc + c);
                const f32x4 v = xv[j] * rstd * g * (sc + 1.0f) + sh;
                v2u o; o.x = pk2(v.x, v.y); o.y = pk2(v.z, v.w);
                *(v2u*)(A + (size_t)row * D + c) = o; }
        }
    }
}

__device__ __forceinline__ int scan_row(int b, int c, int i, int d) {
    const bool isc = c < 4; const int T = isc ? TC : TL, pos = (isc ? c : c - 4) * 64 + i, t = d ? T - 1 - pos : pos;
    return isc ? ML + b * TC + t : b * TL + t;
}
__device__ __forceinline__ void s5_unit(const Args& a, LAS unsigned char* lds, int tid, int lane, int wave, int l, int unit) {
    const int b = unit >> 6, g = (unit >> 1) & 31, d = unit & 1, p = lane;
    const int dg = (l * 2 + d) * 32 + g;
    const float lre = a.in[I_LAMRE][dg * 64 + p], lim = a.in[I_LAMIM][dg * 64 + p], dt = expf(a.in[I_LOGDT][dg]);
    const float mag = expf(lre * dt), ang = lim * dt;
    const float abr = mag * cosf(ang), abi = mag * sinf(ang);
    const float den = lre * lre + lim * lim;
    const float f_re = ((abr - 1.f) * lre + abi * lim) / den, f_im = (abi * lre - (abr - 1.f) * lim) / den;
    float bbr[16], bbi[16], cr[16], ci[16];
#pragma unroll
    for (int h = 0; h < 16; ++h) { const float br = a.in[I_BRE][(size_t)(dg * 64 + p) * 16 + h], bi = a.in[I_BIM][(size_t)(dg * 64 + p) * 16 + h];
        bbr[h] = f_re * br - f_im * bi; bbi[h] = f_re * bi + f_im * br;
        cr[h] = a.in[I_CRE][(size_t)(dg * 16 + h) * 64 + p]; ci[h] = a.in[I_CIM][(size_t)(dg * 16 + h) * 64 + p]; }
    float a64r = abr, a64i = abi;
#pragma unroll
    for (int q = 0; q < 6; ++q) { const float t = a64r * a64r - a64i * a64i; a64i = 2.f * a64r * a64i; a64r = t; }
    LAS float* ub = (LAS float*)(lds + wave * 4096);
    LAS float* E = (LAS float*)(lds + 32768);
    LAS float* SI = (LAS float*)(lds + 32768 + 18432);
    const bf16* P = (const bf16*)(a.ws + WS_PBUF);
    float* Y = (float*)(a.ws + WS_YS5) + (size_t)d * MA * 512;
#define S5_LOAD_U(c) do { const int row_ = scan_row(b, (c), lane, d); const v4u* up_ = (const v4u*)(P + (size_t)row_ * LDP + PC_U + g * 16); const v4u u0_ = up_[0], u1_ = up_[1]; \
        LAS f32x4* ud_ = (LAS f32x4*)(ub + lane * 16); \
        ud_[0] = (f32x4){bflo(u0_.x), bfhi(u0_.x), bflo(u0_.y), bfhi(u0_.y)}; ud_[1] = (f32x4){bflo(u0_.z), bfhi(u0_.z), bflo(u0_.w), bfhi(u0_.w)}; \
        ud_[2] = (f32x4){bflo(u1_.x), bfhi(u1_.x), bflo(u1_.y), bfhi(u1_.y)}; ud_[3] = (f32x4){bflo(u1_.z), bfhi(u1_.z), bflo(u1_.w), bfhi(u1_.w)}; \
        LDS_WAIT(); asm volatile("" ::: "memory"); } while (0)
#define S5_STEP(i) do { const LAS f32x4* us_ = (const LAS f32x4*)(ub + (i) * 16); const f32x4 q0 = us_[0], q1 = us_[1], q2 = us_[2], q3 = us_[3]; \
        const float uu[16] = {q0.x, q0.y, q0.z, q0.w, q1.x, q1.y, q1.z, q1.w, q2.x, q2.y, q2.z, q2.w, q3.x, q3.y, q3.z, q3.w}; \
        float bur = 0.f, bui = 0.f; \
        _Pragma("unroll") for (int h = 0; h < 16; ++h) { bur += bbr[h] * uu[h]; bui += bbi[h] * uu[h]; } \
        const float nr_ = abr * sr - abi * si + bur, ni_ = abr * si + abi * sr + bui; sr = nr_; si = ni_; } while (0)
    for (int c = wave; c < 36; c += 8) {
        S5_LOAD_U(c);
        float sr = 0.f, si = 0.f;
        for (int i = 0; i < 64; ++i) S5_STEP(i);
        E[(c * 64 + p) * 2] = sr; E[(c * 64 + p) * 2 + 1] = si;
        asm volatile("" ::: "memory");
    }
    __syncthreads();
    if (wave == 0) { float cr_ = 0.f, ci_ = 0.f;
        for (int c = 0; c < 36; ++c) { SI[(c * 64 + p) * 2] = cr_; SI[(c * 64 + p) * 2 + 1] = ci_; const float er = E[(c * 64 + p) * 2], ei = E[(c * 64 + p) * 2 + 1];
            const float nr_ = a64r * cr_ - a64i * ci_ + er, ni_ = a64r * ci_ + a64i * cr_ + ei; cr_ = nr_; ci_ = ni_; } }
    __syncthreads();
    for (int c = wave; c < 36; c += 8) {
        S5_LOAD_U(c);
        float sr = SI[(c * 64 + p) * 2], si = SI[(c * 64 + p) * 2 + 1];
        for (int i = 0; i < 64; ++i) {
            S5_STEP(i);
            float v[16];
#pragma unroll
            for (int h = 0; h < 16; ++h) v[h] = cr[h] * sr - ci[h] * si;
            float w8[8], w4[4], w2[2];
            { const bool up = (lane & 32) != 0;
#pragma unroll
              for (int k = 0; k < 8; ++k) { const float send = up ? v[k] : v[k + 8], keep = up ? v[k + 8] : v[k]; w8[k] = keep + __shfl_xor(send, 32); } }
            { const bool up = (lane & 16) != 0;
#pragma unroll
              for (int k = 0; k < 4; ++k) { const float send = up ? w8[k] : w8[k + 4], keep = up ? w8[k + 4] : w8[k]; w4[k] = keep + __shfl_xor(send, 16); } }
            { const bool up = (lane & 8) != 0;
#pragma unroll
              for (int k = 0; k < 2; ++k) { const float send = up ? w4[k] : w4[k + 2], keep = up ? w4[k + 2] : w4[k]; w2[k] = keep + __shfl_xor(send, 8); } }
            float y;
            { const bool up = (lane & 4) != 0; const float send = up ? w2[0] : w2[1], keep = up ? w2[1] : w2[0]; y = keep + __shfl_xor(send, 4); }
            y += __shfl_xor(y, 1); y += __shfl_xor(y, 2);
            const int row = scan_row(b, c, i, d);
            if ((lane & 3) == 0) Y[(size_t)row * 512 + g * 16 + (lane >> 2)] = y;
        }
    }
    __syncthreads();
#undef S5_LOAD_U
#undef S5_STEP
}

__device__ __forceinline__ void gdn_chain(const Args& a, LAS unsigned char* lds, int tid, int l, int chain) {
    const int b = chain / 12, h = (chain >> 1) % 6, d = chain & 1;
    LAS float* qs = (LAS float*)lds; LAS float* ks = qs + 2048; LAS float* vs = ks + 2048; LAS float* egs = vs + 2048; LAS float* bes = egs + 16; LAS int* rws = (LAS int*)(bes + 16);
    const bf16* P = (const bf16*)(a.ws + WS_PBUF); const float* Gt = (const float*)(a.ws + WS_GBUF);
    float* O = (float*)(a.ws + WS_OG) + (size_t)d * MA * 768;
    const int sii = tid >> 5, l32 = tid & 31, c4 = 4 * l32;
    float wq[3][4], wk[3][4], wv[3][4];
    { const float* cw = a.in[I_CONVW] + (size_t)l * 3 * 2304;
#pragma unroll
      for (int j = 0; j < 3; ++j)
#pragma unroll
          for (int e = 0; e < 4; ++e) { wq[j][e] = cw[j * 2304 + h * 128 + c4 + e]; wk[j][e] = cw[j * 2304 + 768 + h * 128 + c4 + e]; wv[j][e] = cw[j * 2304 + 1536 + h * 128 + c4 + e]; } }
    const float nalog = -expf(a.in[I_ALOG][(l * 2 + d) * 6 + h]), dtb = a.in[I_DTB][(l * 2 + d) * 6 + h];
    const int j = tid >> 2, r = tid & 3;
    float S[32];
#pragma unroll
    for (int i = 0; i < 32; ++i) S[i] = 0.f;
    for (int blk = 0; blk < 144; ++blk) {
        const bool isc = blk < 16; const int T = isc ? TC : TL, pos0 = (isc ? blk : blk - 16) * 16;
        {
            const int pos = pos0 + sii, t = d ? T - 1 - pos : pos, row = isc ? ML + b * TC + t : b * TL + t;
            const bf16* pr = P + (size_t)row * LDP + h * 128 + c4;
            const bool hm = t > 0, hp = t < T - 1;
            float yq[4], yk[4], yv[4];
#define GDN_CONV(dst, base, w) do { const v2u x0 = *(const v2u*)(pr + (base)); v2u xm = (v2u){0u, 0u}, xp = (v2u){0u, 0u}; if (hm) xm = *(const v2u*)(pr + (base) - LDP); if (hp) xp = *(const v2u*)(pr + (base) + LDP); \
            dst[0] = siluf(w[0][0] * bflo(xm.x) + w[1][0] * bflo(x0.x) + w[2][0] * bflo(xp.x)); dst[1] = siluf(w[0][1] * bfhi(xm.x) + w[1][1] * bfhi(x0.x) + w[2][1] * bfhi(xp.x)); \
            dst[2] = siluf(w[0][2] * bflo(xm.y) + w[1][2] * bflo(x0.y) + w[2][2] * bflo(xp.y)); dst[3] = siluf(w[0][3] * bfhi(xm.y) + w[1][3] * bfhi(x0.y) + w[2][3] * bfhi(xp.y)); } while (0)
            GDN_CONV(yq, PC_GQ, wq); GDN_CONV(yk, PC_GK, wk); GDN_CONV(yv, PC_GV, wv);
#undef GDN_CONV
            float sq = yq[0] * yq[0] + yq[1] * yq[1] + yq[2] * yq[2] + yq[3] * yq[3], sk = yk[0] * yk[0] + yk[1] * yk[1] + yk[2] * yk[2] + yk[3] * yk[3];
#pragma unroll
            for (int o = 1; o < 32; o <<= 1) { sq += __shfl_xor(sq, o); sk += __shfl_xor(sk, o); }
            const float rq = (1.0f / sqrtf(sq + EPS)) * 0.08838834764831845f, rk = 1.0f / sqrtf(sk + EPS);
            *(LAS f32x4*)(qs + sii * 128 + c4) = (f32x4){yq[0] * rq, yq[1] * rq, yq[2] * rq, yq[3] * rq};
            *(LAS f32x4*)(ks + sii * 128 + c4) = (f32x4){yk[0] * rk, yk[1] * rk, yk[2] * rk, yk[3] * rk};
            *(LAS f32x4*)(vs + sii * 128 + c4) = (f32x4){yv[0], yv[1], yv[2], yv[3]};
            if (l32 == 0) { const float av = Gt[(size_t)row * 128 + GC_A + d * 6 + h], bv = Gt[(size_t)row * 128 + GC_B + d * 6 + h];
                egs[sii] = expf(nalog * softplusf(av + dtb)); bes[sii] = sigm(bv); rws[sii] = row; }
        }
        __syncthreads();
        for (int ii = 0; ii < 16; ++ii) {
            const float eg = egs[ii], be = bes[ii]; const int row = rws[ii];
            float kk[32];
#pragma unroll
            for (int i = 0; i < 8; ++i) { const f32x4 t4 = *(const LAS f32x4*)(ks + ii * 128 + 32 * r + 4 * i); kk[4 * i] = t4.x; kk[4 * i + 1] = t4.y; kk[4 * i + 2] = t4.z; kk[4 * i + 3] = t4.w; }
            float p0 = 0.f, p1 = 0.f, p2 = 0.f, p3 = 0.f;
#pragma unroll
            for (int i = 0; i < 8; ++i) { p0 += S[4 * i] * kk[4 * i]; p1 += S[4 * i + 1] * kk[4 * i + 1]; p2 += S[4 * i + 2] * kk[4 * i + 2]; p3 += S[4 * i + 3] * kk[4 * i + 3]; }
            float kS = (p0 + p1) + (p2 + p3); kS += __shfl_xor(kS, 1); kS += __shfl_xor(kS, 2);
            const float vn = be * (vs[ii * 128 + j] - eg * kS);
            float o0 = 0.f, o1 = 0.f, o2 = 0.f, o3 = 0.f;
#pragma unroll
            for (int i = 0; i < 8; ++i) { const f32x4 q4 = *(const LAS f32x4*)(qs + ii * 128 + 32 * r + 4 * i);
                S[4 * i] = eg * S[4 * i] + kk[4 * i] * vn; S[4 * i + 1] = eg * S[4 * i + 1] + kk[4 * i + 1] * vn; S[4 * i + 2] = eg * S[4 * i + 2] + kk[4 * i + 2] * vn; S[4 * i + 3] = eg * S[4 * i + 3] + kk[4 * i + 3] * vn;
                o0 += S[4 * i] * q4.x; o1 += S[4 * i + 1] * q4.y; o2 += S[4 * i + 2] * q4.z; o3 += S[4 * i + 3] * q4.w; }
            float ov = (o0 + o1) + (o2 + o3); ov += __shfl_xor(ov, 1); ov += __shfl_xor(ov, 2);
            if (r == 0) O[(size_t)row * 768 + h * 128 + j] = ov;
        }
        __syncthreads();
    }
}

__device__ __forceinline__ void mlstm_chain(const Args& a, LAS unsigned char* lds, int tid, int l, int chain) {
    const int b = chain / 12, h = (chain >> 1) % 6, d = chain & 1;
    LAS float* qs = (LAS float*)lds; LAS float* ks = qs + 1024; LAS float* vs = ks + 1024; LAS float* igs = vs + 2048; LAS float* lfs = igs + 16; LAS int* rws = (LAS int*)(lfs + 16);
    const bf16* P = (const bf16*)(a.ws + WS_PBUF); const float* Gt = (const float*)(a.ws + WS_GBUF);
    float* H = (float*)(a.ws + WS_HM) + (size_t)d * MA * 768;
    const int sii = tid >> 5, l32 = tid & 31;
    const float ib = a.in[I_IB][(l * 2 + d) * 6 + h], fb = a.in[I_FB][(l * 2 + d) * 6 + h];
    const int j = tid >> 2, r = tid & 3;
    float Cs[16], ns[16], m = 0.f;
#pragma unroll
    for (int i = 0; i < 16; ++i) { Cs[i] = 0.f; ns[i] = 0.f; }
    for (int blk = 0; blk < 144; ++blk) {
        const bool isc = blk < 16; const int pos0 = (isc ? blk : blk - 16) * 16;
        {
            const int pos = pos0 + sii; int row;
            if (isc) { const int t = d ? TC - 1 - pos : pos; row = ML + b * TC + t; }
            else { const int p = d ? TL - 1 - pos : pos; const int t = (p & 31) * 64 + (p >> 5); row = b * TL + t; }
            const bf16* pr = P + (size_t)row * LDP;
            const unsigned q2 = *(const unsigned*)(pr + PC_MQ + h * 64 + 2 * l32), k2 = *(const unsigned*)(pr + PC_MK + h * 64 + 2 * l32);
            const v2u v4 = *(const v2u*)(pr + PC_MV + h * 128 + 4 * l32);
            *(LAS f32x2*)(qs + sii * 64 + 2 * l32) = (f32x2){bflo(q2) * 0.125f, bfhi(q2) * 0.125f};
            *(LAS f32x2*)(ks + sii * 64 + 2 * l32) = (f32x2){bflo(k2), bfhi(k2)};
            *(LAS f32x4*)(vs + sii * 128 + 4 * l32) = (f32x4){bflo(v4.x), bfhi(v4.x), bflo(v4.y), bfhi(v4.y)};
            if (l32 == 0) { igs[sii] = Gt[(size_t)row * 128 + GC_I + d * 6 + h] + ib; lfs[sii] = logsigmoidf(Gt[(size_t)row * 128 + GC_F + d * 6 + h] + fb); rws[sii] = row; }
        }
        __syncthreads();
        for (int ii = 0; ii < 16; ++ii) {
            const float ig = igs[ii], lf = lfs[ii]; const int row = rws[ii];
            const float mn = fmaxf(lf + m, ig), fp = expf(lf + m - mn), ip = expf(ig - mn); m = mn;
            const float vj = vs[ii * 128 + j] * ip;
            float num = 0.f, den = 0.f;
#pragma unroll
            for (int i = 0; i < 4; ++i) { const f32x4 k4 = *(const LAS f32x4*)(ks + ii * 64 + 16 * r + 4 * i), q4 = *(const LAS f32x4*)(qs + ii * 64 + 16 * r + 4 * i);
                Cs[4 * i] = fp * Cs[4 * i] + k4.x * vj; Cs[4 * i + 1] = fp * Cs[4 * i + 1] + k4.y * vj; Cs[4 * i + 2] = fp * Cs[4 * i + 2] + k4.z * vj; Cs[4 * i + 3] = fp * Cs[4 * i + 3] + k4.w * vj;
                ns[4 * i] = fp * ns[4 * i] + ip * k4.x; ns[4 * i + 1] = fp * ns[4 * i + 1] + ip * k4.y; ns[4 * i + 2] = fp * ns[4 * i + 2] + ip * k4.z; ns[4 * i + 3] = fp * ns[4 * i + 3] + ip * k4.w;
                num += (Cs[4 * i] * q4.x + Cs[4 * i + 1] * q4.y) + (Cs[4 * i + 2] * q4.z + Cs[4 * i + 3] * q4.w);
                den += (ns[4 * i] * q4.x + ns[4 * i + 1] * q4.y) + (ns[4 * i + 2] * q4.z + ns[4 * i + 3] * q4.w); }
            num += __shfl_xor(num, 1); num += __shfl_xor(num, 2); den += __shfl_xor(den, 1); den += __shfl_xor(den, 2);
            const float hv = num / fmaxf(fabsf(den), expf(-m));
            if (r == 0) H[(size_t)row * 768 + h * 128 + j] = hv;
        }
        __syncthreads();
    }
}

__device__ __forceinline__ void finalize_rows(const Args& a, int gw, int NGW, int lane, int nrows, int l) {
    const bf16* P = (const bf16*)(a.ws + WS_PBUF);
    const float* Y0 = (const float*)(a.ws + WS_YS5); const float* Y1 = Y0 + (size_t)MA * 512;
    const float* O0 = (const float*)(a.ws + WS_OG); const float* O1 = O0 + (size_t)MA * 768;
    const float* H0 = (const float*)(a.ws + WS_HM); const float* H1 = H0 + (size_t)MA * 768;
    bf16* MIX = (bf16*)(a.ws + WS_MIX); bf16* Y5 = (bf16*)(a.ws + WS_Y5);
    const float* s5d = a.in[I_S5D] + l * 512; const float* gnorm = a.in[I_GNORM] + l * 128; const float* mnorm = a.in[I_MNORM] + l * 128;
    for (int row = gw; row < nrows; row += NGW) {
        {
            const int c0 = 8 * lane;
            const f32x4 a0 = *(const f32x4*)(Y0 + (size_t)row * 512 + c0), a1 = *(const f32x4*)(Y0 + (size_t)row * 512 + c0 + 4);
            const f32x4 b0 = *(const f32x4*)(Y1 + (size_t)row * 512 + c0), b1 = *(const f32x4*)(Y1 + (size_t)row * 512 + c0 + 4);
            const f32x4 d0 = *(const f32x4*)(s5d + c0), d1 = *(const f32x4*)(s5d + c0 + 4);
            const v4u uu = *(const v4u*)(P + (size_t)row * LDP + PC_U + c0);
            const f32x4 u0 = (f32x4){bflo(uu.x), bfhi(uu.x), bflo(uu.y), bfhi(uu.y)}, u1 = (f32x4){bflo(uu.z), bfhi(uu.z), bflo(uu.w), bfhi(uu.w)};
            const f32x4 y0 = a0 + b0 + d0 * u0, y1 = a1 + b1 + d1 * u1;
            v4u o; o.x = pk2(gelu_tanh(y0.x), gelu_tanh(y0.y)); o.y = pk2(gelu_tanh(y0.z), gelu_tanh(y0.w)); o.z = pk2(gelu_tanh(y1.x), gelu_tanh(y1.y)); o.w = pk2(gelu_tanh(y1.z), gelu_tanh(y1.w));
            *(v4u*)(Y5 + (size_t)row * 512 + c0) = o;
        }
#pragma unroll 1
        for (int hh = 0; hh < 6; ++hh) {
            const int c = hh * 128 + 2 * lane;
            const f32x2 of = *(const f32x2*)(O0 + (size_t)row * 768 + c), ob = *(const f32x2*)(O1 + (size_t)row * 768 + c);
            const float ox = of.x + ob.x, oy = of.y + ob.y;
            const float sc = 1.0f / sqrtf(wave_sum(ox * ox + oy * oy) * (1.0f / 128.f) + EPS);
            const f32x2 gn = *(const f32x2*)(gnorm + 2 * lane);
            const unsigned z2 = *(const unsigned*)(P + (size_t)row * LDP + PC_GZ + c);
            *(unsigned*)(MIX + (size_t)row * D + 512 + c) = pk2(ox * sc * gn.x * siluf(bflo(z2)), oy * sc * gn.y * siluf(bfhi(z2)));
        }
#pragma unroll 1
        for (int hh = 0; hh < 6; ++hh) {
            const int c = hh * 128 + 2 * lane;
            const f32x2 hf = *(const f32x2*)(H0 + (size_t)row * 768 + c), hb = *(const f32x2*)(H1 + (size_t)row * 768 + c);
            const float hx = hf.x + hb.x, hy = hf.y + hb.y;
            const float sc = 1.0f / sqrtf(wave_sum(hx * hx + hy * hy) * (1.0f / 128.f) + EPS);
            const f32x2 gn = *(const f32x2*)(mnorm + 2 * lane);
            const unsigned o2 = *(const unsigned*)(P + (size_t)row * LDP + PC_MO + c);
            *(unsigned*)(MIX + (size_t)row * D + 1280 + c) = pk2(hx * sc * gn.x * sigm(bflo(o2)), hy * sc * gn.y * sigm(bfhi(o2)));
        }
    }
}

constexpr int N_PHASES = 20;
__global__ void __launch_bounds__(NWAVES * 64, 2) fwd_kernel(Args args) {
    extern __shared__ __attribute__((aligned(16))) unsigned char lds_raw[];
    LAS unsigned char* lds = (LAS unsigned char*)lds_raw;
    const int G = gridDim.x, bid = blockIdx.x, NGW = G * NWAVES;
    for (int u = threadIdx.x; u < (LDS_BYTES - LDSCTL_OFF) / 4; u += NWAVES * 64) ((LAS unsigned*)(lds + LDSCTL_OFF))[u] = 0u;
    __syncthreads();
    volatile LAS unsigned* MISC = (volatile LAS unsigned*)(lds + MISC_OFF);
    XcdBarrier bar; bar.bar = (unsigned*)(args.ws + WS_CTL) + CW_BAR; bar.x = 0; bar.st = nullptr;
#if !MK_PER_PHASE
    bar = xcd_barrier_post((unsigned*)(args.ws + WS_CTL) + CW_BAR, MISC + 8);
#endif
    const int lo = args.ph_lo, hi = args.ph_hi;
#define IN(k) (lo <= (k) && (k) < hi)
#define PH_IDS() int tid = threadIdx.x; asm volatile("" : "+v"(tid)); const int lane = tid & 63, wave = __builtin_amdgcn_readfirstlane(tid >> 6), gw = bid * NWAVES + wave; (void)lane; (void)gw
#define SEAM(k) do { if (IN(k) && IN((k) + 1)) xcd_barrier(bar); } while (0)

    if (IN(0)) { PH_IDS(); p0_prologue(args, lds, tid, lane, wave, bid, G); }
    SEAM(0);
    if (IN(1)) { PH_IDS(); rowpass<true, false, false, false, true>(args, gw, NGW, lane, MA, 0, 0, nullptr, 0, args.in[I_NMPRE], 0, 1); }
    SEAM(1);
#pragma unroll 1
    for (int l = 0; l < DEPTH; ++l) {
        const int pb = 2 + 9 * l;
        unsigned char* wl = args.ws + WS_W + (size_t)l * W_LAYER;
        const int Mrows = (l == DEPTH - 1) ? ML : MA;
        if (IN(pb + 0)) {
            pg8::Gemm g{(const pg8::bf16_t*)(args.ws + WS_ABUF), (const pg8::bf16_t*)wl, MA, N1, D}; pg8::StaticOrder S; S.init(MA, N1, G, bid);
            pg8::EpiProj E{(pg8::bf16_t*)(args.ws + WS_PBUF), LDP, (float*)(args.ws + WS_GBUF), GATE_TILE};
            pg8::gemm_phase<pg8::EpiProj, pg8::StaticOrder, true, true>(lds, g, S, E);
        }
        SEAM(pb + 0);
        if (IN(pb + 1)) {
            PH_IDS();
            if (bid < 48) gdn_chain(args, lds, tid, l, bid);
            else if (bid < 96) mlstm_chain(args, lds, tid, l, bid - 48);
            else { for (int u = bid - 96; u < 256; u += G - 96) s5_unit(args, lds, tid, lane, wave, l, u); }
        }
        SEAM(pb + 1);
        if (IN(pb + 2)) { PH_IDS(); finalize_rows(args, gw, NGW, lane, Mrows, l); }
        SEAM(pb + 2);
        if (IN(pb + 3)) {
            pg8::Gemm g{(const pg8::bf16_t*)(args.ws + WS_Y5), (const pg8::bf16_t*)(wl + WGLU_OFF), Mrows, 512, 512}; pg8::StaticOrder S; S.init(Mrows, 512, G, bid);
            pg8::EpiGlu E{(const pg8::bf16_t*)(args.ws + WS_Y5), 512, (pg8::bf16_t*)(args.ws + WS_MIX), D, args.in[I_GLUB] + l * 512};
            pg8::gemm_phase<pg8::EpiGlu, pg8::StaticOrder, true, true>(lds, g, S, E);
        }
        SEAM(pb + 3);
        if (IN(pb + 4)) {
            pg8::Gemm g{(const pg8::bf16_t*)(args.ws + WS_MIX), (const pg8::bf16_t*)(wl + WO_OFF), Mrows, D, D}; pg8::StaticOrder S; S.init(Mrows, D, G, bid);
            pg8::EpiF32 E{(float*)(args.ws + WS_R), D};
            pg8::gemm_phase<pg8::EpiF32, pg8::StaticOrder, true, true>(lds, g, S, E);
        }
        SEAM(pb + 4);
        if (IN(pb + 5)) {
            PH_IDS();
            if (l == 0) rowpass<true, true, true, false, true>(args, gw, NGW, lane, Mrows, l, 2, args.in[I_NMPOST] + l * D, l, args.in[I_NFPRE] + l * D, 3, 4);
            else rowpass<false, true, true, false, true>(args, gw, NGW, lane, Mrows, l, 2, args.in[I_NMPOST] + l * D, l, args.in[I_NFPRE] + l * D, 3, 4);
        }
        SEAM(pb + 5);
        if (IN(pb + 6)) {
            pg8::Gemm g{(const pg8::bf16_t*)(args.ws + WS_ABUF), (const pg8::bf16_t*)(wl + WGU_OFF), Mrows, 2 * FF, D}; pg8::StaticOrder S; S.init(Mrows, 2 * FF, G, bid);
            pg8::EpiSwiGLU E{(pg8::bf16_t*)(args.ws + WS_PBUF), FF};
            pg8::gemm_phase<pg8::EpiSwiGLU, pg8::StaticOrder, true, true>(lds, g, S, E);
        }
        SEAM(pb + 6);
        if (IN(pb + 7)) {
            pg8::Gemm g{(const pg8::bf16_t*)(args.ws + WS_PBUF), (const pg8::bf16_t*)(wl + WD_OFF), Mrows, D, FF}; pg8::StaticOrder S; S.init(Mrows, D, G, bid);
            pg8::EpiF32 E{(float*)(args.ws + WS_R), D};
            pg8::gemm_phase<pg8::EpiF32, pg8::StaticOrder, true, true>(lds, g, S, E);
        }
        SEAM(pb + 7);
        if (IN(pb + 8)) {
            PH_IDS();
            if (l < DEPTH - 1) rowpass<false, true, true, false, true>(args, gw, NGW, lane, Mrows, l, 5, args.in[I_NFPOST] + l * D, l + 1, args.in[I_NMPRE] + (l + 1) * D, 0, 1);
            else rowpass<false, true, false, true, false>(args, gw, NGW, lane, Mrows, l, 5, args.in[I_NFPOST] + l * D, 0, nullptr, 0, 0);
        }
        SEAM(pb + 8);
    }
#undef IN
#undef SEAM
}

extern "C" void kernel_launch(void* const* d_in, const int* in_sizes, int n_in, void* d_out, int out_size, void* d_ws, size_t ws_size, hipStream_t stream) {
    static int grid = 0;
    if (grid == 0) {
        if (n_in != N_IN || in_sizes[0] != ML * D || out_size != ML * D || ws_size < WS_END) {
            fprintf(stderr, "kernel_launch: unexpected shapes (n_in %d, in0 %d, out %d, ws %zu, need %zu); nothing launched\n", n_in, n_in > 0 ? in_sizes[0] : -1, out_size, ws_size, (size_t)WS_END); grid = -1; return; }
        int dev = 0, cus = 0;
        if (hipGetDevice(&dev) != hipSuccess || hipDeviceGetAttribute(&cus, hipDeviceAttributeMultiprocessorCount, dev) != hipSuccess) { grid = -1; return; }
        if (hipFuncSetAttribute((const void*)fwd_kernel, hipFuncAttributeMaxDynamicSharedMemorySize, LDS_BYTES) != hipSuccess) { fprintf(stderr, "kernel_launch: hipFuncSetAttribute failed\n"); grid = -1; return; }
        int per_cu = 0;
        if (hipOccupancyMaxActiveBlocksPerMultiprocessor(&per_cu, (const void*)fwd_kernel, NWAVES * 64, LDS_BYTES) != hipSuccess || per_cu < 1)
            fprintf(stderr, "kernel_launch: occupancy query reports %d workgroups per CU\n", per_cu);
        (void)hipGetLastError();
        grid = cus;
        if (grid != 256) fprintf(stderr, "kernel_launch: %d CUs (built for 256)\n", grid);
    }
    if (grid < 0) return;
    (void)hipMemsetAsync((char*)d_ws + WS_CTL, 0, CTL_ZERO_BYTES, stream);
    Args a{};
    for (int i = 0; i < N_IN; ++i) a.in[i] = (const float*)d_in[i];
    a.out = (float*)d_out; a.ws = (unsigned char*)d_ws;
#if MK_PER_PHASE
    for (int ph = 0; ph < N_PHASES; ++ph) { a.ph_lo = ph; a.ph_hi = ph + 1; a.li = ph; hipLaunchKernelGGL(fwd_kernel, dim3(grid), dim3(NWAVES * 64), LDS_BYTES, stream, a); }
#else
    a.ph_lo = 0; a.ph_hi = N_PHASES; a.li = 0;
    hipLaunchKernelGGL(fwd_kernel, dim3(grid), dim3(NWAVES * 64), LDS_BYTES, stream, a);
#endif
}
```

```cpp
#include <hip/hip_runtime.h>
#include <cstdio>
#include <cstdint>
namespace pg8 {
#define PG8_LAS __attribute__((address_space(3)))
typedef unsigned short bf16_t;
typedef short bf16x8 __attribute__((ext_vector_type(8)));
typedef float f32x4 __attribute__((ext_vector_type(4)));
typedef unsigned u32x4 __attribute__((ext_vector_type(4)));
constexpr int BM = 256, BK = 64, HALF = 128, HTB = HALF * BK * 2  , STAGE_BYTES = 8 * HTB, NXCD = 8, WGM = 8;

__host__ __device__ __forceinline__ int lds_byte(int r, int c) { const int st = (r >> 4) * 2 + (c >> 5), rr = r & 15, cc = c & 31, ob = rr * 64 + cc * 2; return st * 1024 + (ob ^ (((ob >> 9) & 1) << 5)); }
__host__ __device__ __forceinline__ void stage_rc(int b, int& R, int& C) { const int st = b / 1024, sb = b % 1024, swz = sb ^ (((sb >> 9) & 1) << 5); R = (st >> 1) * 16 + swz / 64; C = (st & 1) * 32 + (swz % 64) / 2; }
__host__ __device__ __forceinline__ int perm32(int rho) { const int n = rho >> 4, i = rho & 15; return 8 * (i >> 2) + 4 * n + (i & 3); }

struct Unit { int pm, pn; };
struct Gemm { const bf16_t* A; const bf16_t* Bt; int M, N, K; };

struct StaticOrder {
    int nM, nN, nwg, G, c;
    __host__ __device__ void init(int M, int N, int G_, int c_) { nM = M / BM; nN = N / BM; nwg = nM * nN; G = G_; c = c_; }
    __host__ __device__ bool next(int i, Unit& u) const {
        const long L = (long)i * G + c; if (L >= nwg) return false;
        int wgid = (int)L; { const int q = nwg / NXCD, r = nwg % NXCD, xcd = wgid % NXCD, off = wgid / NXCD; wgid = (xcd < r ? xcd * (q + 1) : r * (q + 1) + (xcd - r) * q) + off; }
        const int nig = WGM * nN, gid = wgid / nig, fm = gid * WGM, gsz = (nM - fm) < WGM ? (nM - fm) : WGM;
        u.pm = fm + ((wgid % nig) % gsz); u.pn = (wgid % nig) / gsz; return true;
    }
    __device__ __forceinline__ void a_ready(const Unit&) const {}
    __device__ __forceinline__ void done(const Unit&) const {}
};

__device__ __forceinline__ unsigned cvt_pk_bf16(float lo, float hi) { unsigned r; asm volatile("v_cvt_pk_bf16_f32 %0, %1, %2" : "=v"(r) : "v"(lo), "v"(hi)); return r; }
__device__ __forceinline__ float bf_lo(unsigned w) { return __uint_as_float(w << 16); }
__device__ __forceinline__ float bf_hi(unsigned w) { return __uint_as_float(w & 0xffff0000u); }
__device__ __forceinline__ float sigmoidf_(float x) { return 1.0f / (1.0f + __expf(-x)); }

struct EpiF32 {
    static constexpr bool PERM = false, AFTER_DRAIN = false;
    float* C; int ldc;
    __device__ __forceinline__ void operator()(const f32x4 (&acc)[2][2][4][2], const Unit& u, int wr, int wc, int fr, int fq) const {
        const int row0 = u.pm * BM + wr * 64 + fr, col0 = u.pn * BM + wc * 32 + 4 * fq;
#pragma unroll
        for (int ai = 0; ai < 2; ++ai)
#pragma unroll
            for (int m = 0; m < 4; ++m) { float* rowp = C + (size_t)(row0 + ai * HALF + m * 16) * ldc + col0;
#pragma unroll
                for (int bj = 0; bj < 2; ++bj)
#pragma unroll
                    for (int n = 0; n < 2; ++n) *(f32x4*)(rowp + bj * HALF + n * 16) = acc[ai][bj][m][n]; }
    }
};
struct EpiProj {
    static constexpr bool PERM = true, AFTER_DRAIN = false;
    bf16_t* P; int ldp; float* G; int gate_tile;
    __device__ __forceinline__ void operator()(const f32x4 (&acc)[2][2][4][2], const Unit& u, int wr, int wc, int fr, int fq) const {
        const int row0 = u.pm * BM + wr * 64 + fr;
        if (u.pn != gate_tile) {
            const int col0 = u.pn * BM + wc * 32 + 8 * fq;
#pragma unroll
            for (int ai = 0; ai < 2; ++ai)
#pragma unroll
                for (int m = 0; m < 4; ++m) { bf16_t* rowp = P + (size_t)(row0 + ai * HALF + m * 16) * ldp + col0;
#pragma unroll
                    for (int bj = 0; bj < 2; ++bj) { const f32x4 v0 = acc[ai][bj][m][0], v1 = acc[ai][bj][m][1];
                        u32x4 w; w.x = cvt_pk_bf16(v0[0], v0[1]); w.y = cvt_pk_bf16(v0[2], v0[3]); w.z = cvt_pk_bf16(v1[0], v1[1]); w.w = cvt_pk_bf16(v1[2], v1[3]);
                        *(u32x4*)(rowp + bj * HALF) = w; } }
        } else {
            const int col0 = wc * 32 + 8 * fq;
#pragma unroll
            for (int ai = 0; ai < 2; ++ai)
#pragma unroll
                for (int m = 0; m < 4; ++m) { float* rowp = G + (size_t)(row0 + ai * HALF + m * 16) * 128 + col0;
                    *(f32x4*)(rowp) = acc[ai][0][m][0]; *(f32x4*)(rowp + 4) = acc[ai][0][m][1]; }
        }
    }
};
struct EpiSwiGLU {
    static constexpr bool PERM = true, AFTER_DRAIN = false;
    bf16_t* O; int ldc;
    __device__ __forceinline__ void operator()(const f32x4 (&acc)[2][2][4][2], const Unit& u, int wr, int wc, int fr, int fq) const {
        const int row0 = u.pm * BM + wr * 64 + fr, col0 = u.pn * HALF + wc * 32 + 8 * fq;
#pragma unroll
        for (int ai = 0; ai < 2; ++ai)
#pragma unroll
            for (int m = 0; m < 4; ++m) { bf16_t* rowp = O + (size_t)(row0 + ai * HALF + m * 16) * ldc + col0;
                float r[8];
#pragma unroll
                for (int n = 0; n < 2; ++n)
#pragma unroll
                    for (int j = 0; j < 4; ++j) { const float g = acc[ai][0][m][n][j], up = acc[ai][1][m][n][j]; r[n * 4 + j] = g * sigmoidf_(g) * up; }
                u32x4 w; w.x = cvt_pk_bf16(r[0], r[1]); w.y = cvt_pk_bf16(r[2], r[3]); w.z = cvt_pk_bf16(r[4], r[5]); w.w = cvt_pk_bf16(r[6], r[7]);
                *(u32x4*)rowp = w; }
    }
};
struct EpiGlu {
    static constexpr bool PERM = true, AFTER_DRAIN = false;
    const bf16_t* Y; int ldy; bf16_t* O; int ldo; const float* bias;
    __device__ __forceinline__ void operator()(const f32x4 (&acc)[2][2][4][2], const Unit& u, int wr, int wc, int fr, int fq) const {
        const int row0 = u.pm * BM + wr * 64 + fr, col0 = u.pn * BM + wc * 32 + 8 * fq;
        f32x4 bv[2][2];
#pragma unroll
        for (int bj = 0; bj < 2; ++bj)
#pragma unroll
            for (int n = 0; n < 2; ++n) bv[bj][n] = *(const f32x4*)(bias + col0 + bj * HALF + 4 * n);
#pragma unroll
        for (int ai = 0; ai < 2; ++ai)
#pragma unroll
            for (int m = 0; m < 4; ++m) { const size_t row = (size_t)(row0 + ai * HALF + m * 16);
#pragma unroll
                for (int bj = 0; bj < 2; ++bj) {
                    const u32x4 yv = *(const u32x4*)(Y + row * ldy + col0 + bj * HALF);
                    const f32x4 v0 = acc[ai][bj][m][0] + bv[bj][0], v1 = acc[ai][bj][m][1] + bv[bj][1];
                    u32x4 w;
                    w.x = cvt_pk_bf16(bf_lo(yv.x) * sigmoidf_(v0[0]), bf_hi(yv.x) * sigmoidf_(v0[1]));
                    w.y = cvt_pk_bf16(bf_lo(yv.y) * sigmoidf_(v0[2]), bf_hi(yv.y) * sigmoidf_(v0[3]));
                    w.z = cvt_pk_bf16(bf_lo(yv.z) * sigmoidf_(v1[0]), bf_hi(yv.z) * sigmoidf_(v1[1]));
                    w.w = cvt_pk_bf16(bf_lo(yv.w) * sigmoidf_(v1[2]), bf_hi(yv.w) * sigmoidf_(v1[3]));
                    *(u32x4*)(O + row * ldo + col0 + bj * HALF) = w; } }
    }
};

template <class Epi, class Sched, bool ALIGN_EPI = false, bool SP2 = false>
__device__ __forceinline__ void gemm_phase(PG8_LAS unsigned char* lds, const Gemm g, const Sched& S, const Epi& E) {
    int tid_ = threadIdx.x; asm volatile("" : "+v"(tid_));
    const int tid = tid_, wid = __builtin_amdgcn_readfirstlane(tid >> 6), lane = tid & 63, wr = wid >> 2, wc = wid & 3, fr = lane & 15, fq = lane >> 4;
    const int K = g.K, nt = K / BK;
    unsigned voffA[2], voffB[2];
#pragma unroll
    for (int i = 0; i < 2; ++i) { int R, C; stage_rc(tid * 16 + i * 8192, R, C); const int Rb = Epi::PERM ? ((R & ~31) + perm32(R & 31)) : R;
        voffA[i] = (unsigned)(R * K + C) * 2u; voffB[i] = (unsigned)(Rb * K + C) * 2u; }
    const size_t kstep = (size_t)(BK * 2);
    const size_t hstep = (size_t)HALF * K * 2;
    const size_t tstep = 2 * hstep;
    const unsigned ldsw = (unsigned)wid * 1024u;
    const int aoff = lds_byte(wr * 64 + fr, fq * 8), boff = lds_byte(wc * 32 + fr, fq * 8);
#define PG8_SA(b, h) (((b) * 2 + (h)) * HTB)
#define PG8_SB(b, h) ((4 + (b) * 2 + (h)) * HTB)
#define PG8_STAGE(bufoff, gbase, voff) do { _Pragma("unroll") for (int _i = 0; _i < 2; ++_i) \
        __builtin_amdgcn_global_load_lds((const unsigned*)((const char*)(gbase) + (voff)[_i]), (PG8_LAS unsigned*)(lds + (bufoff) + ldsw + _i * 8192), 16, 0, 0); } while (0)
#define PG8_LDA(dst, b, h) do { _Pragma("unroll") for (int m = 0; m < 4; ++m) _Pragma("unroll") for (int k = 0; k < 2; ++k) dst[m][k] = *(const PG8_LAS bf16x8*)(lds + PG8_SA(b, h) + aoff + m * 2048 + k * 1024); } while (0)
#define PG8_LDB(dst, b, h) do { _Pragma("unroll") for (int n = 0; n < 2; ++n) _Pragma("unroll") for (int k = 0; k < 2; ++k) dst[n][k] = *(const PG8_LAS bf16x8*)(lds + PG8_SB(b, h) + boff + n * 2048 + k * 1024); } while (0)
#define PG8_MMA(ai, bj, At, Bt) do { __builtin_amdgcn_s_setprio(1); _Pragma("unroll") for (int m = 0; m < 4; ++m) _Pragma("unroll") for (int n = 0; n < 2; ++n) _Pragma("unroll") for (int k = 0; k < 2; ++k) \
        acc[ai][bj][m][n] = __builtin_amdgcn_mfma_f32_16x16x32_bf16(Bt[n][k], At[m][k], acc[ai][bj][m][n], 0, 0, 0); __builtin_amdgcn_s_setprio(0); } while (0)
#define PG8_WAIT_V(n) asm volatile("s_waitcnt vmcnt(" #n ")" ::: "memory")
#define PG8_WAIT_L(n) asm volatile("s_waitcnt lgkmcnt(" #n ")" ::: "memory")
#define PG8_BAR __builtin_amdgcn_s_barrier()
#define PG8_SCHED __builtin_amdgcn_sched_barrier(0)
    Unit cur, nxt; int ui = 0;
    if (!S.next(0, cur)) return;
    f32x4 acc[2][2][4][2];
#pragma unroll
    for (int a = 0; a < 2; ++a)
#pragma unroll
        for (int b = 0; b < 2; ++b)
#pragma unroll
            for (int m = 0; m < 4; ++m)
#pragma unroll
                for (int n = 0; n < 2; ++n) acc[a][b][m][n] = (f32x4){0.f, 0.f, 0.f, 0.f};
    bf16x8 At[4][2], B0[2][2], B1[2][2];
    const char* cA = (const char*)g.A + (size_t)cur.pm * tstep; const char* cB = (const char*)g.Bt + (size_t)cur.pn * tstep;
    S.a_ready(cur);
    if constexpr (SP2) {
        PG8_STAGE(PG8_SB(0, 0), cB, voffB); PG8_STAGE(PG8_SB(0, 1), cB + hstep, voffB); PG8_STAGE(PG8_SA(0, 0), cA, voffA); PG8_STAGE(PG8_SA(0, 1), cA + hstep, voffA);
        if (wr == 1) PG8_BAR;
        PG8_WAIT_V(2); PG8_BAR;
        PG8_STAGE(PG8_SB(1, 0), cB + kstep, voffB); PG8_STAGE(PG8_SA(1, 0), cA + kstep, voffA); PG8_STAGE(PG8_SB(1, 1), cB + hstep + kstep, voffB);
        PG8_WAIT_V(6); PG8_BAR;
    } else {
        PG8_STAGE(PG8_SB(0, 0), cB, voffB); PG8_STAGE(PG8_SA(0, 0), cA, voffA); PG8_STAGE(PG8_SB(0, 1), cB + hstep, voffB); PG8_STAGE(PG8_SA(0, 1), cA + hstep, voffA);
        if (wr == 1) PG8_BAR;
        PG8_WAIT_V(4); PG8_BAR;
        PG8_STAGE(PG8_SB(1, 0), cB + kstep, voffB); PG8_STAGE(PG8_SA(1, 0), cA + kstep, voffA); PG8_STAGE(PG8_SB(1, 1), cB + hstep + kstep, voffB);
        PG8_WAIT_V(6); PG8_BAR;
    }
    for (;;) {
        const bool has_next = S.next(ui + 1, nxt);
        const char* nA = has_next ? (const char*)g.A + (size_t)nxt.pm * tstep : cA; const char* nB = has_next ? (const char*)g.Bt + (size_t)nxt.pn * tstep : cB;
        for (int t = 0; t < nt; t += 2) {
            const bool last = (t == nt - 2);
            const char* a1 = cA + (size_t)(t + 1) * kstep;
            const char* a2 = last ? nA : cA + (size_t)(t + 2) * kstep; const char* b2 = last ? nB : cB + (size_t)(t + 2) * kstep;
            const char* a3 = a2 + kstep; const char* b3 = b2 + kstep;
            if (last && has_next) S.a_ready(nxt);
            if constexpr (SP2) {
            PG8_LDB(B0, 0, 0); PG8_LDB(B1, 0, 1); PG8_SCHED; PG8_LDA(At, 0, 0); PG8_STAGE(PG8_SA(1, 1), a1 + hstep, voffA);
            PG8_WAIT_V(8); PG8_WAIT_L(0); PG8_BAR; PG8_MMA(0, 0, At, B0); PG8_MMA(0, 1, At, B1); PG8_BAR; PG8_SCHED;
            PG8_LDA(At, 0, 1); PG8_STAGE(PG8_SB(0, 0), b2, voffB); PG8_STAGE(PG8_SB(0, 1), b2 + hstep, voffB); PG8_STAGE(PG8_SA(0, 0), a2, voffA);
            PG8_WAIT_V(8); PG8_WAIT_L(0); PG8_BAR; PG8_MMA(1, 0, At, B0); PG8_MMA(1, 1, At, B1); PG8_BAR; PG8_SCHED;
            PG8_LDB(B0, 1, 0); PG8_LDB(B1, 1, 1); PG8_SCHED; PG8_LDA(At, 1, 0); PG8_STAGE(PG8_SA(0, 1), a2 + hstep, voffA);
            PG8_WAIT_V(8); PG8_WAIT_L(0); PG8_BAR; PG8_MMA(0, 0, At, B0); PG8_MMA(0, 1, At, B1); PG8_BAR; PG8_SCHED;
            PG8_LDA(At, 1, 1); PG8_STAGE(PG8_SB(1, 0), b3, voffB); PG8_STAGE(PG8_SB(1, 1), b3 + hstep, voffB); PG8_STAGE(PG8_SA(1, 0), a3, voffA);
            PG8_WAIT_V(8); PG8_WAIT_L(0); PG8_BAR; PG8_MMA(1, 0, At, B0); PG8_MMA(1, 1, At, B1); PG8_BAR; PG8_SCHED;
            } else {
            PG8_LDB(B0, 0, 0); PG8_SCHED; PG8_LDA(At, 0, 0); PG8_STAGE(PG8_SA(1, 1), a1 + hstep, voffA);
            PG8_WAIT_L(8); PG8_BAR; PG8_WAIT_L(0); PG8_MMA(0, 0, At, B0); PG8_BAR; PG8_SCHED;
            PG8_LDB(B1, 0, 1); PG8_STAGE(PG8_SB(0, 0), b2, voffB);
            PG8_BAR; PG8_WAIT_L(0); PG8_MMA(0, 1, At, B1); PG8_BAR;
            PG8_LDA(At, 0, 1); PG8_STAGE(PG8_SA(0, 0), a2, voffA);
            PG8_BAR; PG8_WAIT_L(0); PG8_MMA(1, 0, At, B0); PG8_BAR; PG8_SCHED;
            PG8_STAGE(PG8_SB(0, 1), b2 + hstep, voffB);
            PG8_WAIT_V(6); PG8_BAR; PG8_MMA(1, 1, At, B1); PG8_BAR;
            PG8_LDB(B0, 1, 0); PG8_SCHED; PG8_LDA(At, 1, 0); PG8_STAGE(PG8_SA(0, 1), a2 + hstep, voffA);
            PG8_WAIT_L(8); PG8_BAR; PG8_WAIT_L(0); PG8_MMA(0, 0, At, B0); PG8_BAR; PG8_SCHED;
            PG8_LDB(B1, 1, 1); PG8_STAGE(PG8_SB(1, 0), b3, voffB);
            PG8_BAR; PG8_WAIT_L(0); PG8_MMA(0, 1, At, B1); PG8_BAR;
            PG8_LDA(At, 1, 1); PG8_STAGE(PG8_SA(1, 0), a3, voffA);
            PG8_BAR; PG8_WAIT_L(0); PG8_MMA(1, 0, At, B0); PG8_BAR; PG8_SCHED;
            PG8_STAGE(PG8_SB(1, 1), b3 + hstep, voffB);
            PG8_WAIT_V(6); PG8_BAR; PG8_MMA(1, 1, At, B1); PG8_BAR;
            }
        }
        if constexpr (ALIGN_EPI) { if (wr == 0) PG8_BAR; }
        if constexpr (!Epi::AFTER_DRAIN) { E(acc, cur, wr, wc, fr, fq); S.done(cur); }
        if (!has_next) break;
#pragma unroll
        for (int a = 0; a < 2; ++a)
#pragma unroll
            for (int b = 0; b < 2; ++b)
#pragma unroll
                for (int m = 0; m < 4; ++m)
#pragma unroll
                    for (int n = 0; n < 2; ++n) acc[a][b][m][n] = (f32x4){0.f, 0.f, 0.f, 0.f};
        cur = nxt; cA = nA; cB = nB; ++ui;
        if constexpr (ALIGN_EPI) { if (wr == 1) PG8_BAR; }
    }
    PG8_WAIT_V(0);
    if constexpr (!ALIGN_EPI) { if (wr == 0) PG8_BAR; }
    PG8_BAR;
    if constexpr (Epi::AFTER_DRAIN) { E.fused(acc, cur, wr, wc, fr, fq, lds, wid, lane); S.done(cur); }
#undef PG8_SA
#undef PG8_SB
#undef PG8_STAGE
#undef PG8_LDA
#undef PG8_LDB
#undef PG8_MMA
#undef PG8_WAIT_V
#undef PG8_WAIT_L
#undef PG8_BAR
#undef PG8_SCHED
}
}

#ifndef MK_PER_PHASE
#define MK_PER_PHASE 0
#endif
constexpr int NWAVES = 8;
constexpr int NB = 4, TL = 2048, TC = 256, D = 2048, DEPTH = 2;
constexpr int ML = NB * TL, MC = NB * TC, MA = ML + MC;
constexpr int NPROJ = 5936, N1 = 6144, LDP = 5888, GATE_TILE = 23;
constexpr int FF = 5632;
constexpr float EPS = 1e-6f;
constexpr int PC_U = 0, PC_GQ = 512, PC_GK = 1280, PC_GV = 2048, PC_GZ = 2816, PC_MQ = 3584, PC_MK = 3968, PC_MV = 4352, PC_MO = 5120;
constexpr int GC_A = 0, GC_B = 12, GC_I = 24, GC_F = 36;
enum { I_X = 0, I_C, I_CTX, I_CCTX, I_ADAW, I_ADAB, I_NMPRE, I_NMPOST, I_NFPRE, I_NFPOST, I_WIN, I_WOUT, I_LAMRE, I_LAMIM, I_LOGDT, I_BRE, I_BIM, I_CRE, I_CIM, I_S5D,
       I_GLUW, I_GLUB, I_CONVW, I_ALOG, I_DTB, I_GNORM, I_IB, I_FB, I_MNORM, I_WG, I_WU, I_WD, N_IN };

constexpr size_t MiB = 1u << 20;
constexpr size_t WS_CTL = 0, CTL_ZERO_BYTES = 64 * 1024;
constexpr size_t WS_MODS = 1 * MiB;
constexpr size_t WS_W = 2 * MiB, W_LAYER = 99 * MiB;
constexpr size_t WO_OFF = 24 * MiB, WGU_OFF = 32 * MiB, WD_OFF = 76 * MiB, WGLU_OFF = 98 * MiB;
constexpr size_t WS_XBUF = WS_W + 2 * W_LAYER;
constexpr size_t WS_PBUF = WS_XBUF + 72 * MiB;
constexpr size_t WS_GBUF = WS_PBUF + 104 * MiB;
constexpr size_t WS_YS5 = WS_GBUF + 5 * MiB;
constexpr size_t WS_OG = WS_YS5 + 36 * MiB;
constexpr size_t WS_HM = WS_OG + 54 * MiB;
constexpr size_t WS_R = WS_HM + 54 * MiB;
constexpr size_t WS_ABUF = WS_R + 72 * MiB;
constexpr size_t WS_MIX = WS_ABUF + 36 * MiB;
constexpr size_t WS_Y5 = WS_MIX + 36 * MiB;
constexpr size_t WS_END = WS_Y5 + 9 * MiB;
constexpr size_t WS_GDN = WS_R;
static_assert(WS_GDN + (size_t)1728 * 90368 <= WS_END, "GDN chunk blocks fit their overlay");
static_assert(WS_END <= 768 * MiB, "workspace map");
constexpr int CW_TMO = 0, CW_BAR = 4096;

constexpr int RING_BYTES = 131072, LDS_BYTES = 147456, LDSCTL_OFF = LDS_BYTES - 512, MISC_OFF = LDSCTL_OFF + 320;

#define GAS __attribute__((address_space(1)))
#define LAS __attribute__((address_space(3)))
typedef unsigned short bf16;
typedef unsigned v4u __attribute__((ext_vector_type(4)));
typedef unsigned v2u __attribute__((ext_vector_type(2)));
typedef float f32x4 __attribute__((ext_vector_type(4)));
typedef float f32x2 __attribute__((ext_vector_type(2)));
typedef GAS unsigned gu32;
#define RLX_AGENT __ATOMIC_RELAXED, __HIP_MEMORY_SCOPE_AGENT
#define LDS_WAIT() asm volatile("s_waitcnt lgkmcnt(0)" ::: "memory")
#define VM_WAIT() asm volatile("s_waitcnt vmcnt(0)" ::: "memory")
__device__ __forceinline__ unsigned f2bf(float f) { unsigned u = __builtin_bit_cast(unsigned, f); return (u + 0x7fffu + ((u >> 16) & 1u)) >> 16; }
__device__ __forceinline__ unsigned pk2(float lo, float hi) { return f2bf(lo) | (f2bf(hi) << 16); }
__device__ __forceinline__ float bflo(unsigned w) { return __uint_as_float(w << 16); }
__device__ __forceinline__ float bfhi(unsigned w) { return __uint_as_float(w & 0xffff0000u); }
__device__ __forceinline__ float sigm(float x) { return 1.0f / (1.0f + __expf(-x)); }
__device__ __forceinline__ float siluf(float x) { return x * sigm(x); }
__device__ __forceinline__ float softplusf(float x) { return x > 20.f ? x : log1pf(expf(x)); }
__device__ __forceinline__ float logsigmoidf(float x) { return fminf(x, 0.f) - log1pf(expf(-fabsf(x))); }
__device__ __forceinline__ float gelu_tanh(float x) { return 0.5f * x * (1.0f + tanhf(0.7978845608028654f * (x + 0.044715f * x * x * x))); }
__device__ __forceinline__ float wave_sum(float v) {
#pragma unroll
    for (int o = 1; o < 64; o <<= 1) v += __shfl_xor(v, o);
    return v;
}
#define XB_TMO      128
#define XB_XCNT(j)  (256  + 64 * (j))
#define XB_XSUB(j)  (1280 + 64 * (j))
#define XB_XGEN(j)  (2304 + 64 * (j))
#define XB_TOP      3328
#define XB_TOPGEN   3392
#define XCD_BAR_WORDS 3456
#define XB_SPIN_CAP (1u << 18)

__device__ __forceinline__ unsigned xb_ld(unsigned* p)              { return __hip_atomic_load(p, __ATOMIC_RELAXED, __HIP_MEMORY_SCOPE_AGENT); }
__device__ __forceinline__ unsigned xb_add(unsigned* p, unsigned v) { return __hip_atomic_fetch_add(p, v, __ATOMIC_RELAXED, __HIP_MEMORY_SCOPE_AGENT); }
__device__ __forceinline__ unsigned xb_xcc_id() { return (unsigned)__builtin_amdgcn_s_getreg((3 << 11) | 20) & 0xFu; }
#define XB_SPIN(cond, bar) do { unsigned _sp = 0; while (cond) { __builtin_amdgcn_s_sleep(1); \
    if ((++_sp & 255u) == 0u) { if (xb_ld(&(bar)[XB_TMO])) break; if (_sp > XB_SPIN_CAP) { atomicAdd(&(bar)[XB_TMO], 1u); break; } } } } while (0)

struct XcdBarrier {
    unsigned* bar; unsigned x;
    volatile LAS unsigned* st;
};

__device__ __forceinline__ XcdBarrier xcd_barrier_post(unsigned* bar, volatile LAS unsigned* st) {
    XcdBarrier b; b.bar = bar; b.x = xb_xcc_id(); b.st = st;
    if (threadIdx.x == 0) (void)xb_add(&bar[XB_XCNT(b.x)], 1u);
    return b;
}
__device__ __forceinline__ void xcd_barrier_complete(unsigned* bar, unsigned x, unsigned& nloc, unsigned& nx) {
    const unsigned G = gridDim.x * gridDim.y * gridDim.z;
    unsigned sum, cnt, mine, sp = 0u;
    for (;;) {
        sum = 0u; cnt = 0u; mine = 0u;
#pragma unroll
        for (unsigned j = 0; j < 16; ++j) { const unsigned c = xb_ld(&bar[XB_XCNT(j)]); sum += c; cnt += (c > 0u) ? 1u : 0u; mine = (j == x) ? c : mine; }
        if (sum == G) break;
        __builtin_amdgcn_s_sleep(1);
        if ((++sp & 255u) == 0u) { if (xb_ld(&bar[XB_TMO])) break; if (sp > XB_SPIN_CAP) { atomicAdd(&bar[XB_TMO], 1u); break; } }
    }
    nloc = mine > 0u ? mine : 1u; nx = cnt > 0u ? cnt : 1u;
}

__device__ __forceinline__ void xcd_barrier(const XcdBarrier& b) {
    asm volatile("s_waitcnt vmcnt(0)" ::: "memory");
    __syncthreads();
    if (threadIdx.x == 0) {
        unsigned* bar = b.bar;
        __builtin_amdgcn_s_waitcnt(0);
        unsigned nloc = b.st[0], nx = b.st[1];
        if (nloc == 0u) { xcd_barrier_complete(bar, b.x, nloc, nx); b.st[0] = nloc; b.st[1] = nx; }
        const unsigned old = xb_add(&bar[XB_XSUB(b.x)], 1u);
        const unsigned gen = old / nloc;
        if (old + 1u == (gen + 1u) * nloc) {
            __builtin_amdgcn_fence(__ATOMIC_RELEASE, "agent");
            asm volatile("s_waitcnt vmcnt(0)" ::: "memory");
            const unsigned og = xb_add(&bar[XB_TOP], 1u);
            const unsigned tg = og / nx;
            if (og + 1u == (tg + 1u) * nx) xb_add(&bar[XB_TOPGEN], 1u);
            else XB_SPIN(xb_ld(&bar[XB_TOPGEN]) == tg, bar);
            __builtin_amdgcn_fence(__ATOMIC_ACQUIRE, "agent");
            xb_add(&bar[XB_XGEN(b.x)], 1u);
            asm volatile("s_waitcnt vmcnt(0)" ::: "memory");
        } else {
            XB_SPIN(xb_ld(&bar[XB_XGEN(b.x)]) == gen, bar);
            __builtin_amdgcn_fence(__ATOMIC_ACQUIRE, "agent");
            asm volatile("s_waitcnt vmcnt(0)" ::: "memory");
        }
    }
    __syncthreads();
}

struct Args { const float* in[N_IN]; float* out; unsigned char* ws; int ph_lo, ph_hi, li, pad; };

template <int MODE> __device__ __forceinline__ int dst_row(int n) {
    if (MODE == 1) return n < 3584 ? n : (n < 3608 ? 5888 + (n - 3584) : (n < 5912 ? n - 24 : n));
    if (MODE == 2) return 256 * (n >> 7) + (n & 127);
    if (MODE == 3) return 256 * (n >> 7) + 128 + (n & 127);
    return n;
}
template <int MODE> __device__ __forceinline__ void transpose_item(const float* W, int K, int N, bf16* WT, LAS float* scr, int item, int lane) {
    const int nblk = (N + 31) / 32, kb = item / nblk, nb = item % nblk, k0 = 64 * kb, n0 = 32 * nb;
    const int nn = n0 + (lane & 31);
#pragma unroll 8
    for (int i = 0; i < 32; ++i) { const int kk = 2 * i + (lane >> 5); scr[kk * 33 + (lane & 31)] = nn < N ? W[(size_t)(k0 + kk) * N + nn] : 0.f; }
    LDS_WAIT(); asm volatile("" ::: "memory");
    const int c = lane & 7;
#pragma unroll
    for (int j = 0; j < 4; ++j) { const int nl = (lane >> 3) + 8 * j, n = n0 + nl; const LAS float* s = scr + (8 * c) * 33 + nl;
        v4u o; o.x = pk2(s[0 * 33], s[1 * 33]); o.y = pk2(s[2 * 33], s[3 * 33]); o.z = pk2(s[4 * 33], s[5 * 33]); o.w = pk2(s[6 * 33], s[7 * 33]);
        if (n < N) *(GAS v4u*)(WT + (size_t)dst_row<MODE>(n) * K + k0 + 8 * c) = o; }
    LDS_WAIT(); asm volatile("" ::: "memory");
}
__device__ __forceinline__ void p0_prologue(const Args& a, LAS unsigned char* lds, int tid, int lane, int wave, int bid, int G) {
    {
        LAS float* sc = (LAS float*)lds;
        LAS float* red = (LAS float*)(lds + 40960);
        float* mods = (float*)(a.ws + WS_MODS);
        for (int i = tid; i < 5 * D; i += NWAVES * 64) { const int r = i >> 11, k = i & 2047; const float v = r < 4 ? a.in[I_C][r * D + k] : a.in[I_CCTX][k]; sc[i] = siluf(v); }
        __syncthreads();
        for (int unit = bid; unit < 192; unit += G) {
            const int l = unit / 96, n0 = (unit % 96) * 128;
            const float* W = a.in[I_ADAW] + (size_t)l * D * (6 * D) + n0 + 2 * lane;
            float acc[5][2];
#pragma unroll
            for (int r = 0; r < 5; ++r) { acc[r][0] = 0.f; acc[r][1] = 0.f; }
            const int kbeg = wave * 256;
#pragma unroll 8
            for (int kk = 0; kk < 256; ++kk) { const int k = kbeg + kk; const f32x2 w = *(const f32x2*)(W + (size_t)k * (6 * D));
#pragma unroll
                for (int r = 0; r < 5; ++r) { const float s = sc[r * D + k]; acc[r][0] += s * w.x; acc[r][1] += s * w.y; } }
#pragma unroll
            for (int r = 0; r < 5; ++r) { red[(wave * 5 + r) * 128 + 2 * lane] = acc[r][0]; red[(wave * 5 + r) * 128 + 2 * lane + 1] = acc[r][1]; }
            __syncthreads();
            for (int o = tid; o < 640; o += NWAVES * 64) { const int r = o >> 7, c = o & 127; float s = 0.f;
#pragma unroll
                for (int w = 0; w < 8; ++w) s += red[(w * 5 + r) * 128 + c];
                mods[(size_t)(l * 5 + r) * (6 * D) + n0 + c] = s + a.in[I_ADAB][l * 6 * D + n0 + c]; }
            __syncthreads();
        }
    }
    {
        LAS float* scr = (LAS float*)(lds + 61440 + wave * 8448);
        const int gw = bid * NWAVES + wave, NGW = G * NWAVES;
        constexpr int IT_IN = 32 * 186, IT_OUT = 32 * 64, IT_G = 32 * 176, IT_D = 88 * 64, IT_GLU = 8 * 16, IT_LAYER = IT_IN + IT_OUT + 2 * IT_G + IT_D + IT_GLU;
        for (int it = gw; it < DEPTH * IT_LAYER; it += NGW) {
            const int l = it / IT_LAYER; int r = it % IT_LAYER; unsigned char* wl = a.ws + WS_W + (size_t)l * W_LAYER;
            if (r < IT_IN) { transpose_item<1>(a.in[I_WIN] + (size_t)l * D * NPROJ, D, NPROJ, (bf16*)wl, scr, r, lane); continue; } r -= IT_IN;
            if (r < IT_OUT) { transpose_item<0>(a.in[I_WOUT] + (size_t)l * D * D, D, D, (bf16*)(wl + WO_OFF), scr, r, lane); continue; } r -= IT_OUT;
            if (r < IT_G) { transpose_item<2>(a.in[I_WG] + (size_t)l * D * FF, D, FF, (bf16*)(wl + WGU_OFF), scr, r, lane); continue; } r -= IT_G;
            if (r < IT_G) { transpose_item<3>(a.in[I_WU] + (size_t)l * D * FF, D, FF, (bf16*)(wl + WGU_OFF), scr, r, lane); continue; } r -= IT_G;
            if (r < IT_D) { transpose_item<0>(a.in[I_WD] + (size_t)l * FF * D, FF, D, (bf16*)(wl + WD_OFF), scr, r, lane); continue; } r -= IT_D;
            transpose_item<0>(a.in[I_GLUW] + (size_t)l * 512 * 512, 512, 512, (bf16*)(wl + WGLU_OFF), scr, r, lane);
        }
        constexpr int ZV = (N1 - NPROJ) * D * 2 / 16;
        for (int i = bid * NWAVES * 64 + tid; i < DEPTH * ZV; i += G * NWAVES * 64) { const int l = i / ZV, r = i % ZV;
            *(GAS v4u*)(a.ws + WS_W + (size_t)l * W_LAYER + (size_t)NPROJ * D * 2 + (size_t)r * 16) = (v4u){0u, 0u, 0u, 0u}; }
    }
}

template <bool SRC_IN, bool HAS_R, bool WRITE_X, bool WRITE_OUT, bool MAKE_A>
__device__ __forceinline__ void rowpass(const Args& a, int gw, int NGW, int lane, int nrows, int l, int gate_chunk, const float* gpost, int la, const float* gpre, int sh_chunk, int sc_chunk) {
    const float* mods = (const float*)(a.ws + WS_MODS);
    float* xbuf = (float*)(a.ws + WS_XBUF);
    const float* R = (const float*)(a.ws + WS_R);
    bf16* A = (bf16*)(a.ws + WS_ABUF);
    for (int row = gw; row < nrows; row += NGW) {
        const int r5 = row < ML ? row / TL : 4;
        const float* xs = SRC_IN ? (row < ML ? a.in[I_X] + (size_t)row * D : a.in[I_CTX] + (size_t)(row - ML) * D) : xbuf + (size_t)row * D;
        f32x4 xv[8];
#pragma unroll
        for (int j = 0; j < 8; ++j) xv[j] = *(const f32x4*)(xs + 4 * lane + 256 * j);
        if (HAS_R) {
            f32x4 rv[8]; float ss = 0.f;
#pragma unroll
            for (int j = 0; j < 8; ++j) { rv[j] = *(const f32x4*)(R + (size_t)row * D + 4 * lane + 256 * j); ss += (rv[j].x * rv[j].x + rv[j].y * rv[j].y) + (rv[j].z * rv[j].z + rv[j].w * rv[j].w); }
            const float rstd = 1.0f / sqrtf(wave_sum(ss) * (1.0f / D) + EPS);
            const float* mg = mods + ((size_t)(l * 5 + r5) * 6 + gate_chunk) * D;
#pragma unroll
            for (int j = 0; j < 8; ++j) { const int c = 4 * lane + 256 * j; const f32x4 g = *(const f32x4*)(gpost + c), gt = *(const f32x4*)(mg + c);
                xv[j] = xv[j] + gt * (rv[j] * rstd * g);
                if (WRITE_X) *(f32x4*)(xbuf + (size_t)row * D + c) = xv[j];
                if (WRITE_OUT) *(f32x4*)(a.out + (size_t)row * D + c) = xv[j]; }
        }
        if (MAKE_A) {
            float ss = 0.f;
#pragma unroll
            for (int j = 0; j < 8; ++j) ss += (xv[j].x * xv[j].x + xv[j].y * xv[j].y) + (xv[j].z * xv[j].z + xv[j].w * xv[j].w);
            const float rstd = 1.0f / sqrtf(wave_sum(ss) * (1.0f / D) + EPS);
            const float* msh = mods + ((size_t)(la * 5 + r5) * 6 + sh_chunk) * D; const float* msc = mods + ((size_t)(la * 5 + r5) * 6 + sc_chunk) * D;
#pragma unroll
            for (int j = 0; j < 8; ++j) { const int c = 4 * lane + 256 * j; const f32x4 g = *(const f32x4*)(gpre + c), sh = *(const f32x4*)(msh + c), sc = *(const f32x4*)(msc + c);
                const f32x4 v = xv[j] * rstd * g * (sc + 1.0f) + sh;
                v2u o; o.x = pk2(v.x, v.y); o.y = pk2(v.z, v.w);
                *(v2u*)(A + (size_t)row * D + c) = o; }
        }
    }
}

__device__ __forceinline__ int scan_row(int b, int c, int i, int d) {
    const bool isc = c < 4; const int T = isc ? TC : TL, pos = (isc ? c : c - 4) * 64 + i, t = d ? T - 1 - pos : pos;
    return isc ? ML + b * TC + t : b * TL + t;
}
__device__ __forceinline__ void s5_unit(const Args& a, LAS unsigned char* lds, int tid_in, int l, int unit) {
    int tid = tid_in; asm volatile("" : "+v"(tid));
    const int lane = tid & 63, wave = __builtin_amdgcn_readfirstlane(tid >> 6);
    const int b = unit >> 6, g = (unit >> 1) & 31, d = unit & 1, p = lane;
    const int dg = (l * 2 + d) * 32 + g;
    const float lre = a.in[I_LAMRE][dg * 64 + p], lim = a.in[I_LAMIM][dg * 64 + p], dt = expf(a.in[I_LOGDT][dg]);
    const float mag = expf(lre * dt), ang = lim * dt;
    const float abr = mag * cosf(ang), abi = mag * sinf(ang);
    const float den = lre * lre + lim * lim;
    const float f_re = ((abr - 1.f) * lre + abi * lim) / den, f_im = (abi * lre - (abr - 1.f) * lim) / den;
    float bbr[16], bbi[16], cr[16], ci[16];
#pragma unroll
    for (int h = 0; h < 16; ++h) { const float br = a.in[I_BRE][(size_t)(dg * 64 + p) * 16 + h], bi = a.in[I_BIM][(size_t)(dg * 64 + p) * 16 + h];
        bbr[h] = f_re * br - f_im * bi; bbi[h] = f_re * bi + f_im * br;
        cr[h] = a.in[I_CRE][(size_t)(dg * 16 + h) * 64 + p]; ci[h] = a.in[I_CIM][(size_t)(dg * 16 + h) * 64 + p]; }
    float a64r = abr, a64i = abi;
#pragma unroll
    for (int q = 0; q < 6; ++q) { const float t = a64r * a64r - a64i * a64i; a64i = 2.f * a64r * a64i; a64r = t; }
    LAS float* ub = (LAS float*)(lds + wave * 4096);
    LAS float* E = (LAS float*)(lds + 32768);
    LAS float* SI = (LAS float*)(lds + 32768 + 18432);
    const bf16* P = (const bf16*)(a.ws + WS_PBUF);
    float* Y = (float*)(a.ws + WS_YS5) + (size_t)d * MA * 512;
#define S5_LOAD_U(c) do { const int row_ = scan_row(b, (c), lane, d); const v4u* up_ = (const v4u*)(P + (size_t)row_ * LDP + PC_U + g * 16); const v4u u0_ = up_[0], u1_ = up_[1]; \
        LAS f32x4* ud_ = (LAS f32x4*)(ub + lane * 16); \
        ud_[0] = (f32x4){bflo(u0_.x), bfhi(u0_.x), bflo(u0_.y), bfhi(u0_.y)}; ud_[1] = (f32x4){bflo(u0_.z), bfhi(u0_.z), bflo(u0_.w), bfhi(u0_.w)}; \
        ud_[2] = (f32x4){bflo(u1_.x), bfhi(u1_.x), bflo(u1_.y), bfhi(u1_.y)}; ud_[3] = (f32x4){bflo(u1_.z), bfhi(u1_.z), bflo(u1_.w), bfhi(u1_.w)}; \
        LDS_WAIT(); asm volatile("" ::: "memory"); } while (0)
#define S5_STEP(i) do { const LAS f32x4* us_ = (const LAS f32x4*)(ub + (i) * 16); const f32x4 q0 = us_[0], q1 = us_[1], q2 = us_[2], q3 = us_[3]; \
        const float uu[16] = {q0.x, q0.y, q0.z, q0.w, q1.x, q1.y, q1.z, q1.w, q2.x, q2.y, q2.z, q2.w, q3.x, q3.y, q3.z, q3.w}; \
        float bur = 0.f, bui = 0.f; \
        _Pragma("unroll") for (int h = 0; h < 16; ++h) { bur += bbr[h] * uu[h]; bui += bbi[h] * uu[h]; } \
        const float nr_ = abr * sr - abi * si + bur, ni_ = abr * si + abi * sr + bui; sr = nr_; si = ni_; } while (0)
    for (int c = wave; c < 36; c += 8) {
        S5_LOAD_U(c);
        float sr = 0.f, si = 0.f;
        for (int i = 0; i < 64; ++i) S5_STEP(i);
        E[(c * 64 + p) * 2] = sr; E[(c * 64 + p) * 2 + 1] = si;
        asm volatile("" ::: "memory");
    }
    __syncthreads();
    if (wave == 0) { float cr_ = 0.f, ci_ = 0.f;
        for (int c = 0; c < 36; ++c) { SI[(c * 64 + p) * 2] = cr_; SI[(c * 64 + p) * 2 + 1] = ci_; const float er = E[(c * 64 + p) * 2], ei = E[(c * 64 + p) * 2 + 1];
            const float nr_ = a64r * cr_ - a64i * ci_ + er, ni_ = a64r * ci_ + a64i * cr_ + ei; cr_ = nr_; ci_ = ni_; } }
    __syncthreads();
    for (int c = wave; c < 36; c += 8) {
        S5_LOAD_U(c);
        float sr = SI[(c * 64 + p) * 2], si = SI[(c * 64 + p) * 2 + 1];
        for (int i = 0; i < 64; ++i) {
            S5_STEP(i);
            float v[16];
#pragma unroll
            for (int h = 0; h < 16; ++h) v[h] = cr[h] * sr - ci[h] * si;
            float w8[8], w4[4], w2[2];
            { const bool up = (lane & 32) != 0;
#pragma unroll
              for (int k = 0; k < 8; ++k) { const float send = up ? v[k] : v[k + 8], keep = up ? v[k + 8] : v[k]; w8[k] = keep + __shfl_xor(send, 32); } }
            { const bool up = (lane & 16) != 0;
#pragma unroll
              for (int k = 0; k < 4; ++k) { const float send = up ? w8[k] : w8[k + 4], keep = up ? w8[k + 4] : w8[k]; w4[k] = keep + __shfl_xor(send, 16); } }
            { const bool up = (lane & 8) != 0;
#pragma unroll
              for (int k = 0; k < 2; ++k) { const float send = up ? w4[k] : w4[k + 2], keep = up ? w4[k + 2] : w4[k]; w2[k] = keep + __shfl_xor(send, 8); } }
            float y;
            { const bool up = (lane & 4) != 0; const float send = up ? w2[0] : w2[1], keep = up ? w2[1] : w2[0]; y = keep + __shfl_xor(send, 4); }
            y += __shfl_xor(y, 1); y += __shfl_xor(y, 2);
            const int row = scan_row(b, c, i, d);
            if ((lane & 3) == 0) Y[(size_t)row * 512 + g * 16 + (lane >> 2)] = y;
        }
    }
    __syncthreads();
#undef S5_LOAD_U
#undef S5_STEP
}

__device__ __forceinline__ void gdn_chain(const Args& a, LAS unsigned char* lds, int tid, int l, int chain) {
    const int b = chain / 12, h = (chain >> 1) % 6, d = chain & 1;
    LAS float* qs = (LAS float*)lds; LAS float* ks = qs + 2048; LAS float* vs = ks + 2048; LAS float* egs = vs + 2048; LAS float* bes = egs + 16; LAS int* rws = (LAS int*)(bes + 16);
    const bf16* P = (const bf16*)(a.ws + WS_PBUF); const float* Gt = (const float*)(a.ws + WS_GBUF);
    float* O = (float*)(a.ws + WS_OG) + (size_t)d * MA * 768;
    const int sii = tid >> 5, l32 = tid & 31, c4 = 4 * l32;
    float wq[3][4], wk[3][4], wv[3][4];
    { const float* cw = a.in[I_CONVW] + (size_t)l * 3 * 2304;
#pragma unroll
      for (int j = 0; j < 3; ++j)
#pragma unroll
          for (int e = 0; e < 4; ++e) { wq[j][e] = cw[j * 2304 + h * 128 + c4 + e]; wk[j][e] = cw[j * 2304 + 768 + h * 128 + c4 + e]; wv[j][e] = cw[j * 2304 + 1536 + h * 128 + c4 + e]; } }
    const float nalog = -expf(a.in[I_ALOG][(l * 2 + d) * 6 + h]), dtb = a.in[I_DTB][(l * 2 + d) * 6 + h];
    const int j = tid >> 2, r = tid & 3;
    float S[32];
#pragma unroll
    for (int i = 0; i < 32; ++i) S[i] = 0.f;
    for (int blk = 0; blk < 144; ++blk) {
        const bool isc = blk < 16; const int T = isc ? TC : TL, pos0 = (isc ? blk : blk - 16) * 16;
        {
            const int pos = pos0 + sii, t = d ? T - 1 - pos : pos, row = isc ? ML + b * TC + t : b * TL + t;
            const bf16* pr = P + (size_t)row * LDP + h * 128 + c4;
            const bool hm = t > 0, hp = t < T - 1;
            float yq[4], yk[4], yv[4];
#define GDN_CONV(dst, base, w) do { const v2u x0 = *(const v2u*)(pr + (base)); v2u xm = (v2u){0u, 0u}, xp = (v2u){0u, 0u}; if (hm) xm = *(const v2u*)(pr + (base) - LDP); if (hp) xp = *(const v2u*)(pr + (base) + LDP); \
            dst[0] = siluf(w[0][0] * bflo(xm.x) + w[1][0] * bflo(x0.x) + w[2][0] * bflo(xp.x)); dst[1] = siluf(w[0][1] * bfhi(xm.x) + w[1][1] * bfhi(x0.x) + w[2][1] * bfhi(xp.x)); \
            dst[2] = siluf(w[0][2] * bflo(xm.y) + w[1][2] * bflo(x0.y) + w[2][2] * bflo(xp.y)); dst[3] = siluf(w[0][3] * bfhi(xm.y) + w[1][3] * bfhi(x0.y) + w[2][3] * bfhi(xp.y)); } while (0)
            GDN_CONV(yq, PC_GQ, wq); GDN_CONV(yk, PC_GK, wk); GDN_CONV(yv, PC_GV, wv);
#undef GDN_CONV
            float sq = yq[0] * yq[0] + yq[1] * yq[1] + yq[2] * yq[2] + yq[3] * yq[3], sk = yk[0] * yk[0] + yk[1] * yk[1] + yk[2] * yk[2] + yk[3] * yk[3];
#pragma unroll
            for (int o = 1; o < 32; o <<= 1) { sq += __shfl_xor(sq, o); sk += __shfl_xor(sk, o); }
            const float rq = (1.0f / sqrtf(sq + EPS)) * 0.08838834764831845f, rk = 1.0f / sqrtf(sk + EPS);
            *(LAS f32x4*)(qs + sii * 128 + c4) = (f32x4){yq[0] * rq, yq[1] * rq, yq[2] * rq, yq[3] * rq};
            *(LAS f32x4*)(ks + sii * 128 + c4) = (f32x4){yk[0] * rk, yk[1] * rk, yk[2] * rk, yk[3] * rk};
            *(LAS f32x4*)(vs + sii * 128 + c4) = (f32x4){yv[0], yv[1], yv[2], yv[3]};
            if (l32 == 0) { const float av = Gt[(size_t)row * 128 + GC_A + d * 6 + h], bv = Gt[(size_t)row * 128 + GC_B + d * 6 + h];
                egs[sii] = expf(nalog * softplusf(av + dtb)); bes[sii] = sigm(bv); rws[sii] = row; }
        }
        __syncthreads();
        for (int ii = 0; ii < 16; ++ii) {
            const float eg = egs[ii], be = bes[ii]; const int row = rws[ii];
            float kk[32];
#pragma unroll
            for (int i = 0; i < 8; ++i) { const f32x4 t4 = *(const LAS f32x4*)(ks + ii * 128 + 32 * r + 4 * i); kk[4 * i] = t4.x; kk[4 * i + 1] = t4.y; kk[4 * i + 2] = t4.z; kk[4 * i + 3] = t4.w; }
            float p0 = 0.f, p1 = 0.f, p2 = 0.f, p3 = 0.f;
#pragma unroll
            for (int i = 0; i < 8; ++i) { p0 += S[4 * i] * kk[4 * i]; p1 += S[4 * i + 1] * kk[4 * i + 1]; p2 += S[4 * i + 2] * kk[4 * i + 2]; p3 += S[4 * i + 3] * kk[4 * i + 3]; }
            float kS = (p0 + p1) + (p2 + p3); kS += __shfl_xor(kS, 1); kS += __shfl_xor(kS, 2);
            const float vn = be * (vs[ii * 128 + j] - eg * kS);
            float o0 = 0.f, o1 = 0.f, o2 = 0.f, o3 = 0.f;
#pragma unroll
            for (int i = 0; i < 8; ++i) { const f32x4 q4 = *(const LAS f32x4*)(qs + ii * 128 + 32 * r + 4 * i);
                S[4 * i] = eg * S[4 * i] + kk[4 * i] * vn; S[4 * i + 1] = eg * S[4 * i + 1] + kk[4 * i + 1] * vn; S[4 * i + 2] = eg * S[4 * i + 2] + kk[4 * i + 2] * vn; S[4 * i + 3] = eg * S[4 * i + 3] + kk[4 * i + 3] * vn;
                o0 += S[4 * i] * q4.x; o1 += S[4 * i + 1] * q4.y; o2 += S[4 * i + 2] * q4.z; o3 += S[4 * i + 3] * q4.w; }
            float ov = (o0 + o1) + (o2 + o3); ov += __shfl_xor(ov, 1); ov += __shfl_xor(ov, 2);
            if (r == 0) O[(size_t)row * 768 + h * 128 + j] = ov;
        }
        __syncthreads();
    }
}

__device__ __forceinline__ void mlstm_chain(const Args& a, LAS unsigned char* lds, int tid, int l, int chain) {
    const int b = chain / 12, h = (chain >> 1) % 6, d = chain & 1;
    LAS float* qs = (LAS float*)lds; LAS float* ks = qs + 1024; LAS float* vs = ks + 1024; LAS float* igs = vs + 2048; LAS float* lfs = igs + 16; LAS int* rws = (LAS int*)(lfs + 16);
    const bf16* P = (const bf16*)(a.ws + WS_PBUF); const float* Gt = (const float*)(a.ws + WS_GBUF);
    float* H = (float*)(a.ws + WS_HM) + (size_t)d * MA * 768;
    const int sii = tid >> 5, l32 = tid & 31;
    const float ib = a.in[I_IB][(l * 2 + d) * 6 + h], fb = a.in[I_FB][(l * 2 + d) * 6 + h];
    const int j = tid >> 2, r = tid & 3;
    float Cs[16], ns[16], m = 0.f;
#pragma unroll
    for (int i = 0; i < 16; ++i) { Cs[i] = 0.f; ns[i] = 0.f; }
    for (int blk = 0; blk < 144; ++blk) {
        const bool isc = blk < 16; const int pos0 = (isc ? blk : blk - 16) * 16;
        {
            const int pos = pos0 + sii; int row;
            if (isc) { const int t = d ? TC - 1 - pos : pos; row = ML + b * TC + t; }
            else { const int p = d ? TL - 1 - pos : pos; const int t = (p & 31) * 64 + (p >> 5); row = b * TL + t; }
            const bf16* pr = P + (size_t)row * LDP;
            const unsigned q2 = *(const unsigned*)(pr + PC_MQ + h * 64 + 2 * l32), k2 = *(const unsigned*)(pr + PC_MK + h * 64 + 2 * l32);
            const v2u v4 = *(const v2u*)(pr + PC_MV + h * 128 + 4 * l32);
            *(LAS f32x2*)(qs + sii * 64 + 2 * l32) = (f32x2){bflo(q2) * 0.125f, bfhi(q2) * 0.125f};
            *(LAS f32x2*)(ks + sii * 64 + 2 * l32) = (f32x2){bflo(k2), bfhi(k2)};
            *(LAS f32x4*)(vs + sii * 128 + 4 * l32) = (f32x4){bflo(v4.x), bfhi(v4.x), bflo(v4.y), bfhi(v4.y)};
            if (l32 == 0) { igs[sii] = Gt[(size_t)row * 128 + GC_I + d * 6 + h] + ib; lfs[sii] = logsigmoidf(Gt[(size_t)row * 128 + GC_F + d * 6 + h] + fb); rws[sii] = row; }
        }
        __syncthreads();
        for (int ii = 0; ii < 16; ++ii) {
            const float ig = igs[ii], lf = lfs[ii]; const int row = rws[ii];
            const float mn = fmaxf(lf + m, ig), fp = expf(lf + m - mn), ip = expf(ig - mn); m = mn;
            const float vj = vs[ii * 128 + j] * ip;
            float num = 0.f, den = 0.f;
#pragma unroll
            for (int i = 0; i < 4; ++i) { const f32x4 k4 = *(const LAS f32x4*)(ks + ii * 64 + 16 * r + 4 * i), q4 = *(const LAS f32x4*)(qs + ii * 64 + 16 * r + 4 * i);
                Cs[4 * i] = fp * Cs[4 * i] + k4.x * vj; Cs[4 * i + 1] = fp * Cs[4 * i + 1] + k4.y * vj; Cs[4 * i + 2] = fp * Cs[4 * i + 2] + k4.z * vj; Cs[4 * i + 3] = fp * Cs[4 * i + 3] + k4.w * vj;
                ns[4 * i] = fp * ns[4 * i] + ip * k4.x; ns[4 * i + 1] = fp * ns[4 * i + 1] + ip * k4.y; ns[4 * i + 2] = fp * ns[4 * i + 2] + ip * k4.z; ns[4 * i + 3] = fp * ns[4 * i + 3] + ip * k4.w;
                num += (Cs[4 * i] * q4.x + Cs[4 * i + 1] * q4.y) + (Cs[4 * i + 2] * q4.z + Cs[4 * i + 3] * q4.w);
                den += (ns[4 * i] * q4.x + ns[4 * i + 1] * q4.y) + (ns[4 * i + 2] * q4.z + ns[4 * i + 3] * q4.w); }
            num += __shfl_xor(num, 1); num += __shfl_xor(num, 2); den += __shfl_xor(den, 1); den += __shfl_xor(den, 2);
            const float hv = num / fmaxf(fabsf(den), expf(-m));
            if (r == 0) H[(size_t)row * 768 + h * 128 + j] = hv;
        }
        __syncthreads();
    }
}

__device__ __forceinline__ void finalize_rows(const Args& a, int gw, int NGW, int lane, int nrows, int l) {
    const bf16* P = (const bf16*)(a.ws + WS_PBUF);
    const float* Y0 = (const float*)(a.ws + WS_YS5); const float* Y1 = Y0 + (size_t)MA * 512;
    const float* O0 = (const float*)(a.ws + WS_OG); const float* O1 = O0 + (size_t)MA * 768;
    const float* H0 = (const float*)(a.ws + WS_HM); const float* H1 = H0 + (size_t)MA * 768;
    bf16* MIX = (bf16*)(a.ws + WS_MIX); bf16* Y5 = (bf16*)(a.ws + WS_Y5);
    const float* s5d = a.in[I_S5D] + l * 512; const float* gnorm = a.in[I_GNORM] + l * 128; const float* mnorm = a.in[I_MNORM] + l * 128;
    for (int row = gw; row < nrows; row += NGW) {
        {
            const int c0 = 8 * lane;
            const f32x4 a0 = *(const f32x4*)(Y0 + (size_t)row * 512 + c0), a1 = *(const f32x4*)(Y0 + (size_t)row * 512 + c0 + 4);
            const f32x4 b0 = *(const f32x4*)(Y1 + (size_t)row * 512 + c0), b1 = *(const f32x4*)(Y1 + (size_t)row * 512 + c0 + 4);
            const f32x4 d0 = *(const f32x4*)(s5d + c0), d1 = *(const f32x4*)(s5d + c0 + 4);
            const v4u uu = *(const v4u*)(P + (size_t)row * LDP + PC_U + c0);
            const f32x4 u0 = (f32x4){bflo(uu.x), bfhi(uu.x), bflo(uu.y), bfhi(uu.y)}, u1 = (f32x4){bflo(uu.z), bfhi(uu.z), bflo(uu.w), bfhi(uu.w)};
            const f32x4 y0 = a0 + b0 + d0 * u0, y1 = a1 + b1 + d1 * u1;
            v4u o; o.x = pk2(gelu_tanh(y0.x), gelu_tanh(y0.y)); o.y = pk2(gelu_tanh(y0.z), gelu_tanh(y0.w)); o.z = pk2(gelu_tanh(y1.x), gelu_tanh(y1.y)); o.w = pk2(gelu_tanh(y1.z), gelu_tanh(y1.w));
            *(v4u*)(Y5 + (size_t)row * 512 + c0) = o;
        }
#pragma unroll 1
        for (int hh = 0; hh < 6; ++hh) {
            const int c = hh * 128 + 2 * lane;
            const f32x2 of = *(const f32x2*)(O0 + (size_t)row * 768 + c), ob = *(const f32x2*)(O1 + (size_t)row * 768 + c);
            const float ox = of.x + ob.x, oy = of.y + ob.y;
            const float sc = 1.0f / sqrtf(wave_sum(ox * ox + oy * oy) * (1.0f / 128.f) + EPS);
            const f32x2 gn = *(const f32x2*)(gnorm + 2 * lane);
            const unsigned z2 = *(const unsigned*)(P + (size_t)row * LDP + PC_GZ + c);
            *(unsigned*)(MIX + (size_t)row * D + 512 + c) = pk2(ox * sc * gn.x * siluf(bflo(z2)), oy * sc * gn.y * siluf(bfhi(z2)));
        }
#pragma unroll 1
        for (int hh = 0; hh < 6; ++hh) {
            const int c = hh * 128 + 2 * lane;
            const f32x2 hf = *(const f32x2*)(H0 + (size_t)row * 768 + c), hb = *(const f32x2*)(H1 + (size_t)row * 768 + c);
            const float hx = hf.x + hb.x, hy = hf.y + hb.y;
            const float sc = 1.0f / sqrtf(wave_sum(hx * hx + hy * hy) * (1.0f / 128.f) + EPS);
            const f32x2 gn = *(const f32x2*)(mnorm + 2 * lane);
            const unsigned o2 = *(const unsigned*)(P + (size_t)row * LDP + PC_MO + c);
            *(unsigned*)(MIX + (size_t)row * D + 1280 + c) = pk2(hx * sc * gn.x * sigm(bflo(o2)), hy * sc * gn.y * sigm(bfhi(o2)));
        }
    }
}

typedef short bf16x8 __attribute__((ext_vector_type(8)));
__device__ __forceinline__ f32x4 mfma16(bf16x8 a, bf16x8 b, f32x4 c) { return __builtin_amdgcn_mfma_f32_16x16x32_bf16(a, b, c, 0, 0, 0); }
__device__ __forceinline__ bf16x8 ldsfrag(const LAS unsigned char* p) { return *(const LAS bf16x8*)p; }
__device__ __forceinline__ bf16x8 glbfrag(const unsigned char* p) { return *(const bf16x8*)p; }
__device__ __forceinline__ float bf2f(unsigned short v) { return __uint_as_float((unsigned)v << 16); }

constexpr size_t GB_W = 0, GB_QD = 16384, GB_KDT = 32768, GB_QKD = 49152, GB_UT = 57344, GB_GT = 90112, GB_BYTES = 90368;
__device__ __forceinline__ void gdn_prep_unit(const Args& a, LAS unsigned char* lds, int tid_in, int l, int unit) {
    int tid = tid_in; asm volatile("" : "+v"(tid));
    const int lane = tid & 63, wave = __builtin_amdgcn_readfirstlane(tid >> 6);
    const int h = unit % 6, c = (unit / 6) % 36, b = unit / 216;
    LAS unsigned char* Qh = lds;
    LAS unsigned char* Kh = lds + 17408;
    LAS float* Vf = (LAS float*)(lds + 34816);
    LAS float* Mm = (LAS float*)(lds + 67584);
    LAS float* gcs = (LAS float*)(lds + 100352);
    LAS float* Kf = (LAS float*)(lds + 101376);
    LAS float* bes = gcs + 128;
    LAS float* scl = (LAS float*)(lds + 134144);
    const bf16* P = (const bf16*)(a.ws + WS_PBUF); const float* Gt = (const float*)(a.ws + WS_GBUF);
    const bool isc = c < 4; const int T = isc ? TC : TL, t0 = (isc ? c : c - 4) * 64, row0 = isc ? ML + b * TC + t0 : b * TL + t0;
    unsigned char* const blk0 = a.ws + WS_GDN + ((size_t)((b * 6 + h) * 2 + 0) * 36 + c) * GB_BYTES;
    unsigned char* const blk1 = a.ws + WS_GDN + ((size_t)((b * 6 + h) * 2 + 1) * 36 + (isc ? 3 - c : 39 - c)) * GB_BYTES;
#define BLK(d) ((d) ? blk1 : blk0)
    const int q = lane >> 4, r16 = lane & 15;
    {
        const int l32 = tid & 31, tg = tid >> 5, c4 = 4 * l32;
        float wq[3][4], wk[3][4], wv[3][4];
        { const float* cw = a.in[I_CONVW] + (size_t)l * 3 * 2304;
#pragma unroll
          for (int j = 0; j < 3; ++j)
#pragma unroll
              for (int e = 0; e < 4; ++e) { wq[j][e] = cw[j * 2304 + h * 128 + c4 + e]; wk[j][e] = cw[j * 2304 + 768 + h * 128 + c4 + e]; wv[j][e] = cw[j * 2304 + 1536 + h * 128 + c4 + e]; } }
#pragma unroll 1
        for (int rr = 0; rr < 4; ++rr) {
            const int n = tg + 16 * rr, t = t0 + n;
            const bf16* pr = P + (size_t)(row0 + n) * LDP + h * 128 + c4;
            const bool hm = t > 0, hp = t < T - 1;
            float yq[4], yk[4], yv[4];
#define GDN_CONV(dst, base, w) do { const v2u x0 = *(const v2u*)(pr + (base)); v2u xm = (v2u){0u, 0u}, xp = (v2u){0u, 0u}; if (hm) xm = *(const v2u*)(pr + (base) - LDP); if (hp) xp = *(const v2u*)(pr + (base) + LDP); \
            dst[0] = siluf(w[0][0] * bflo(xm.x) + w[1][0] * bflo(x0.x) + w[2][0] * bflo(xp.x)); dst[1] = siluf(w[0][1] * bfhi(xm.x) + w[1][1] * bfhi(x0.x) + w[2][1] * bfhi(xp.x)); \
            dst[2] = siluf(w[0][2] * bflo(xm.y) + w[1][2] * bflo(x0.y) + w[2][2] * bflo(xp.y)); dst[3] = siluf(w[0][3] * bfhi(xm.y) + w[1][3] * bfhi(x0.y) + w[2][3] * bfhi(xp.y)); } while (0)
            GDN_CONV(yq, PC_GQ, wq); GDN_CONV(yk, PC_GK, wk); GDN_CONV(yv, PC_GV, wv);
#undef GDN_CONV
            float sq = yq[0] * yq[0] + yq[1] * yq[1] + yq[2] * yq[2] + yq[3] * yq[3], sk = yk[0] * yk[0] + yk[1] * yk[1] + yk[2] * yk[2] + yk[3] * yk[3];
#pragma unroll
            for (int o = 1; o < 32; o <<= 1) { sq += __shfl_xor(sq, o); sk += __shfl_xor(sk, o); }
            const float rq = (1.0f / sqrtf(sq + EPS)) * 0.08838834764831845f, rk = 1.0f / sqrtf(sk + EPS);
            *(LAS v2u*)(Qh + n * 272 + c4 * 2) = (v2u){pk2(yq[0] * rq, yq[1] * rq), pk2(yq[2] * rq, yq[3] * rq)};
            *(LAS v2u*)(Kh + n * 272 + c4 * 2) = (v2u){pk2(yk[0] * rk, yk[1] * rk), pk2(yk[2] * rk, yk[3] * rk)};
            *(LAS f32x4*)(Vf + n * 128 + c4) = (f32x4){yv[0], yv[1], yv[2], yv[3]};
            *(LAS f32x4*)(Kf + n * 128 + c4) = (f32x4){yk[0] * rk, yk[1] * rk, yk[2] * rk, yk[3] * rk};
        }
    }
    if (wave < 2) {
        const int d = wave, n = d ? 63 - lane : lane;
        const float av = Gt[(size_t)(row0 + n) * 128 + GC_A + d * 6 + h], bv = Gt[(size_t)(row0 + n) * 128 + GC_B + d * 6 + h];
        float g = -expf(a.in[I_ALOG][(l * 2 + d) * 6 + h]) * softplusf(av + a.in[I_DTB][(l * 2 + d) * 6 + h]);
#pragma unroll
        for (int o = 1; o < 64; o <<= 1) { const float t_ = __shfl_up(g, o); if (lane >= o) g += t_; }
        const float bsg = sigm(bv);
        gcs[d * 64 + lane] = g; bes[d * 64 + lane] = bsg; scl[d * 128 + lane] = bsg; scl[d * 128 + 64 + lane] = bsg * __expf(g);
    }
    __syncthreads();
    {
        const int mt = wave & 3; const bool isq = wave >= 4;
        const LAS unsigned char* Ab = (isq ? Qh : Kh) + (16 * mt + r16) * 272 + 16 * q;
        bf16x8 af[4];
#pragma unroll
        for (int ks = 0; ks < 4; ++ks) af[ks] = ldsfrag(Ab + 64 * ks);
#pragma unroll
        for (int nt = 0; nt < 4; ++nt) {
            f32x4 acc = (f32x4){0.f, 0.f, 0.f, 0.f};
#pragma unroll
            for (int ks = 0; ks < 4; ++ks) acc = mfma16(af[ks], ldsfrag(Kh + (16 * nt + r16) * 272 + 16 * q + 64 * ks), acc);
            const int n2 = 16 * nt + r16;
#pragma unroll
            for (int d = 0; d < 2; ++d) {
                const int j = d ? 63 - n2 : n2; const float gj = gcs[d * 64 + j];
#pragma unroll
                for (int rg = 0; rg < 4; ++rg) { const int n1 = 16 * mt + 4 * q + rg, i = d ? 63 - n1 : n1; const float gi = gcs[d * 64 + i];
                    if (!isq) { Mm[(d * 64 + i) * 64 + j] = j < i ? bes[d * 64 + i] * acc[rg] * __expf(gi - gj) : 0.f; }
                    else { *(unsigned short*)(BLK(d) + GB_QKD + (size_t)(i * 64 + j) * 2) = (unsigned short)f2bf(j <= i ? acc[rg] * __expf(gi - gj) : 0.f); } }
            }
        }
    }
    __syncthreads();
    {
        const int d = wave >> 2, cg = wave & 3, col = 64 * (cg & 1) + lane; const bool isk = cg >= 2;
        const LAS float* Md = Mm + d * 4096;
        const LAS float* src = isk ? Kf : Vf;
        const int idx0 = d ? 63 * 128 + col : col, istep = d ? -128 : 128, sc0 = d * 128 + (isk ? 64 : 0);
        float x[64];
#pragma unroll
        for (int i = 0; i < 64; ++i) {
            int o = idx0 + i * istep, o2 = sc0;
            if (i > 0) asm volatile("" : "+v"(o), "+v"(o2) : "v"(x[i - 1]));
            float acc = scl[o2 + i] * src[o];
#pragma unroll
            for (int j4 = 0; j4 < (i + 3) / 4; ++j4) { const f32x4 m4 = *(const LAS f32x4*)(Md + i * 64 + 4 * j4);
                if (4 * j4 + 0 < i) acc -= m4.x * x[4 * j4 + 0];
                if (4 * j4 + 1 < i) acc -= m4.y * x[4 * j4 + 1];
                if (4 * j4 + 2 < i) acc -= m4.z * x[4 * j4 + 2];
                if (4 * j4 + 3 < i) acc -= m4.w * x[4 * j4 + 3]; }
            x[i] = acc;
        }
        if (!isk) { float* up = (float*)(BLK(d) + GB_UT) + (size_t)col * 64;
#pragma unroll
            for (int i4 = 0; i4 < 16; ++i4) *(f32x4*)(up + 4 * i4) = (f32x4){x[4 * i4], x[4 * i4 + 1], x[4 * i4 + 2], x[4 * i4 + 3]}; }
        else { unsigned short* wp = (unsigned short*)(BLK(d) + GB_W) + col;
#pragma unroll
            for (int i = 0; i < 64; ++i) wp[i * 128] = (unsigned short)f2bf(x[i]); }
    }
    {
#pragma unroll 1
        for (int it = tid; it < 2048; it += NWAVES * 64) { const int d = it >> 10, i = (it >> 4) & 63, ch = it & 15, n = d ? 63 - i : i; const float sc = __expf(gcs[d * 64 + i]);
            const v4u w = *(const LAS v4u*)(Qh + n * 272 + ch * 16);
            v4u o; o.x = pk2(bflo(w.x) * sc, bfhi(w.x) * sc); o.y = pk2(bflo(w.y) * sc, bfhi(w.y) * sc); o.z = pk2(bflo(w.z) * sc, bfhi(w.z) * sc); o.w = pk2(bflo(w.w) * sc, bfhi(w.w) * sc);
            *(v4u*)(BLK(d) + GB_QD + (size_t)(i * 128 + ch * 8) * 2) = o; }
#pragma unroll 1
        for (int it = tid; it < 2048; it += NWAVES * 64) { const int d = it >> 10, aa = (it >> 3) & 127, j0 = (it & 7) * 8; const float gl = gcs[d * 64 + 63];
            float v[8];
#pragma unroll
            for (int jj = 0; jj < 8; ++jj) { const int j = j0 + jj, n = d ? 63 - j : j; v[jj] = bf2f(*(const LAS unsigned short*)(Kh + n * 272 + aa * 2)) * __expf(gl - gcs[d * 64 + j]); }
            v4u o; o.x = pk2(v[0], v[1]); o.y = pk2(v[2], v[3]); o.z = pk2(v[4], v[5]); o.w = pk2(v[6], v[7]);
            *(v4u*)(BLK(d) + GB_KDT + (size_t)(aa * 64 + j0) * 2) = o; }
        if (tid < 2) *(float*)(BLK(tid) + GB_GT) = __expf(gcs[tid * 64 + 63]);
    }
    __syncthreads();
#undef BLK
}

__device__ __forceinline__ void gdn_scan_unit(const Args& a, LAS unsigned char* lds, int tid, int lane, int wave, int unit) {
    const int s = unit & 3, chain = unit >> 2, b = chain / 12, h = (chain >> 1) % 6, d = chain & 1;
    const unsigned char* gp = a.ws + WS_GDN + (size_t)chain * 36 * GB_BYTES;
    LAS unsigned char* St = lds;
    LAS unsigned char* VNt = lds + 8704;
    float* O = (float*)(a.ws + WS_OG) + (size_t)d * MA * 768;
    const int q = lane >> 4, r16 = lane & 15, wm = wave & 3; const bool lead = wave < 4;
    for (int i = tid; i < 8704 / 4; i += NWAVES * 64) ((LAS unsigned*)St)[i] = 0u;
    f32x4 accS[2] = {(f32x4){0.f, 0.f, 0.f, 0.f}, (f32x4){0.f, 0.f, 0.f, 0.f}};
    bf16x8 fa[4], fkd[2], fqk[2]; f32x4 uu[2]; float gt;
#define GDN_LOADF(cs) do { const unsigned char* bp_ = gp + (size_t)(cs) * GB_BYTES; \
        _Pragma("unroll") for (int ks = 0; ks < 4; ++ks) fa[ks] = glbfrag(bp_ + (lead ? GB_W : GB_QD) + (size_t)((16 * wm + r16) * 128 + 32 * ks + 8 * q) * 2); \
        _Pragma("unroll") for (int ks = 0; ks < 2; ++ks) fkd[ks] = glbfrag(bp_ + GB_KDT + (size_t)((16 * wave + r16) * 64 + 32 * ks + 8 * q) * 2); \
        _Pragma("unroll") for (int ks = 0; ks < 2; ++ks) fqk[ks] = glbfrag(bp_ + GB_QKD + (size_t)((16 * wm + r16) * 64 + 32 * ks + 8 * q) * 2); \
        _Pragma("unroll") for (int nt = 0; nt < 2; ++nt) uu[nt] = *(const f32x4*)(bp_ + GB_UT + (size_t)((32 * s + 16 * nt + r16) * 64 + 16 * wm + 4 * q) * 4); \
        gt = *(const float*)(bp_ + GB_GT); } while (0)
    GDN_LOADF(0);
    __syncthreads();
#pragma unroll 1
    for (int cs = 0; cs < 36; ++cs) {
        f32x4 acc[2] = {(f32x4){0.f, 0.f, 0.f, 0.f}, (f32x4){0.f, 0.f, 0.f, 0.f}};
#pragma unroll
        for (int nt = 0; nt < 2; ++nt)
#pragma unroll
            for (int ks = 0; ks < 4; ++ks) acc[nt] = mfma16(fa[ks], ldsfrag(St + (16 * nt + r16) * 272 + 64 * ks + 16 * q), acc[nt]);
        if (lead) {
#pragma unroll
            for (int nt = 0; nt < 2; ++nt) { const f32x4 vn = uu[nt] - acc[nt];
                *(LAS v2u*)(VNt + (16 * nt + r16) * 144 + (16 * wm + 4 * q) * 2) = (v2u){pk2(vn.x, vn.y), pk2(vn.z, vn.w)}; }
        }
        const bf16x8 kd0 = fkd[0], kd1 = fkd[1], qk0 = fqk[0], qk1 = fqk[1]; const float gtc = gt;
        __syncthreads();
        if (cs + 1 < 36) GDN_LOADF(cs + 1);
        bf16x8 vf[2][2];
#pragma unroll
        for (int nt = 0; nt < 2; ++nt)
#pragma unroll
            for (int ks = 0; ks < 2; ++ks) vf[nt][ks] = ldsfrag(VNt + (16 * nt + r16) * 144 + 64 * ks + 16 * q);
        if (!lead) {
#pragma unroll
            for (int nt = 0; nt < 2; ++nt) { acc[nt] = mfma16(qk0, vf[nt][0], acc[nt]); acc[nt] = mfma16(qk1, vf[nt][1], acc[nt]); }
#pragma unroll
            for (int rg = 0; rg < 4; ++rg) { const int row = scan_row(b, cs, 16 * wm + 4 * q + rg, d);
#pragma unroll
                for (int nt = 0; nt < 2; ++nt) O[(size_t)row * 768 + h * 128 + 32 * s + 16 * nt + r16] = acc[nt][rg]; }
        }
#pragma unroll
        for (int nt = 0; nt < 2; ++nt) { accS[nt] = accS[nt] * gtc; accS[nt] = mfma16(kd0, vf[nt][0], accS[nt]); accS[nt] = mfma16(kd1, vf[nt][1], accS[nt]);
            *(LAS v2u*)(St + (16 * nt + r16) * 272 + (16 * wave + 4 * q) * 2) = (v2u){pk2(accS[nt].x, accS[nt].y), pk2(accS[nt].z, accS[nt].w)}; }
        __syncthreads();
    }
#undef GDN_LOADF
}

__device__ __forceinline__ void mlstm_chunk_chain(const Args& a, LAS unsigned char* lds, int tid, int lane, int wave, int l, int chain) {
    const int b = chain / 12, h = (chain >> 1) % 6, d = chain & 1;
    LAS unsigned char* Qs = lds;
    LAS unsigned char* Ks = lds + 9216;
    LAS unsigned char* KwT = lds + 18432;
    LAS unsigned char* Sd = lds + 27648;
    LAS unsigned char* Vt = lds + 36864;
    LAS unsigned char* Ct = lds + 57600;
    LAS float* sc = (LAS float*)(lds + 78336);
    const bf16* P = (const bf16*)(a.ws + WS_PBUF); const float* Gt = (const float*)(a.ws + WS_GBUF);
    float* H = (float*)(a.ws + WS_HM) + (size_t)d * MA * 768;
    const float ib = a.in[I_IB][(l * 2 + d) * 6 + h], fb = a.in[I_FB][(l * 2 + d) * 6 + h];
    const int q = lane >> 4, r16 = lane & 15, wm = wave & 3, wg = wave >> 2;
    for (int i = tid; i < (57600 + 20736 - 36864) / 4; i += NWAVES * 64) ((LAS unsigned*)Vt)[i] = 0u;
    __syncthreads();
    for (int i = tid; i < 32; i += NWAVES * 64) ((LAS unsigned*)(Vt + 128 * 144))[i] = 0x3f803f80u;
    f32x4 accC[5];
#pragma unroll
    for (int k = 0; k < 5; ++k) accC[k] = (f32x4){0.f, 0.f, 0.f, 0.f};
    float m_st = 0.f;
#pragma unroll 1
    for (int cs = 0; cs < 36; ++cs) {
        const bool isc = cs < 4; const int pos0 = (isc ? cs : cs - 4) * 64;
        if (wave == 0) {
            const int pos = pos0 + lane; int row;
            if (isc) { const int t = d ? TC - 1 - pos : pos; row = ML + b * TC + t; }
            else { const int p = d ? TL - 1 - pos : pos; row = b * TL + (p & 31) * 64 + (p >> 5); }
            const float ig = Gt[(size_t)row * 128 + GC_I + d * 6 + h] + ib; float bb = logsigmoidf(Gt[(size_t)row * 128 + GC_F + d * 6 + h] + fb);
#pragma unroll
            for (int o = 1; o < 64; o <<= 1) { const float t_ = __shfl_up(bb, o); if (lane >= o) bb += t_; }
            const float av = ig - bb; float cm = av;
#pragma unroll
            for (int o = 1; o < 64; o <<= 1) { const float t_ = __shfl_up(cm, o); if (lane >= o) cm = fmaxf(cm, t_); }
            sc[lane] = bb; sc[64 + lane] = av; sc[128 + lane] = cm; ((LAS int*)sc)[192 + lane] = row;
        }
        __syncthreads();
        const float b63 = sc[63], cm63 = sc[128 + 63];
        const float m_chunk = b63 + cm63, m_new = fmaxf(b63 + m_st, m_chunk), a_old = __expf(b63 + m_st - m_new), a_new = __expf(m_chunk - m_new);
        {
            const int j = tid >> 3, l8 = tid & 7; const int row = ((const LAS int*)sc)[192 + j];
            const bf16* pr = P + (size_t)row * LDP;
            const v4u q8 = *(const v4u*)(pr + PC_MQ + h * 64 + 8 * l8), k8 = *(const v4u*)(pr + PC_MK + h * 64 + 8 * l8);
            const v4u v0 = *(const v4u*)(pr + PC_MV + h * 128 + 16 * l8), v1 = *(const v4u*)(pr + PC_MV + h * 128 + 16 * l8 + 8);
            v4u qo; qo.x = pk2(bflo(q8.x) * 0.125f, bfhi(q8.x) * 0.125f); qo.y = pk2(bflo(q8.y) * 0.125f, bfhi(q8.y) * 0.125f); qo.z = pk2(bflo(q8.z) * 0.125f, bfhi(q8.z) * 0.125f); qo.w = pk2(bflo(q8.w) * 0.125f, bfhi(q8.w) * 0.125f);
            *(LAS v4u*)(Qs + j * 144 + 16 * l8) = qo; *(LAS v4u*)(Ks + j * 144 + 16 * l8) = k8;
            const float wj = __expf(sc[64 + j] - cm63) * a_new;
            const unsigned kk[4] = {k8.x, k8.y, k8.z, k8.w};
#pragma unroll
            for (int e = 0; e < 4; ++e) { *(LAS unsigned short*)(KwT + (8 * l8 + 2 * e) * 144 + j * 2) = (unsigned short)f2bf(bflo(kk[e]) * wj); *(LAS unsigned short*)(KwT + (8 * l8 + 2 * e + 1) * 144 + j * 2) = (unsigned short)f2bf(bfhi(kk[e]) * wj); }
            const unsigned vv[8] = {v0.x, v0.y, v0.z, v0.w, v1.x, v1.y, v1.z, v1.w};
#pragma unroll
            for (int e = 0; e < 8; ++e) { *(LAS unsigned short*)(Vt + (16 * l8 + 2 * e) * 144 + j * 2) = (unsigned short)(vv[e] & 0xffffu); *(LAS unsigned short*)(Vt + (16 * l8 + 2 * e + 1) * 144 + j * 2) = (unsigned short)(vv[e] >> 16); }
        }
        __syncthreads();
        {
            const bf16x8 ka0 = ldsfrag(Ks + (16 * wm + r16) * 144 + 16 * q), ka1 = ldsfrag(Ks + (16 * wm + r16) * 144 + 64 + 16 * q);
#pragma unroll
            for (int t2 = 0; t2 < 2; ++t2) { const int it = 2 * wg + t2;
                f32x4 acc = (f32x4){0.f, 0.f, 0.f, 0.f};
                acc = mfma16(ka0, ldsfrag(Qs + (16 * it + r16) * 144 + 16 * q), acc); acc = mfma16(ka1, ldsfrag(Qs + (16 * it + r16) * 144 + 64 + 16 * q), acc);
                const int i = 16 * it + r16; const float cmi = sc[128 + i]; float sv[4];
#pragma unroll
                for (int rg = 0; rg < 4; ++rg) { const int j = 16 * wm + 4 * q + rg; sv[rg] = j <= i ? acc[rg] * __expf(sc[64 + j] - cmi) : 0.f; }
                *(LAS v2u*)(Sd + i * 144 + (16 * wm + 4 * q) * 2) = (v2u){pk2(sv[0], sv[1]), pk2(sv[2], sv[3])}; }
        }
        __syncthreads();
        {
            const bf16x8 sa0 = ldsfrag(Sd + (16 * wm + r16) * 144 + 16 * q), sa1 = ldsfrag(Sd + (16 * wm + r16) * 144 + 64 + 16 * q);
            const bf16x8 qa0 = ldsfrag(Qs + (16 * wm + r16) * 144 + 16 * q), qa1 = ldsfrag(Qs + (16 * wm + r16) * 144 + 64 + 16 * q);
            f32x4 nI = (f32x4){0.f, 0.f, 0.f, 0.f}, nC = (f32x4){0.f, 0.f, 0.f, 0.f};
            nI = mfma16(sa0, ldsfrag(Vt + (128 + r16) * 144 + 16 * q), nI); nI = mfma16(sa1, ldsfrag(Vt + (128 + r16) * 144 + 64 + 16 * q), nI);
            nC = mfma16(qa0, ldsfrag(Ct + (128 + r16) * 144 + 16 * q), nC); nC = mfma16(qa1, ldsfrag(Ct + (128 + r16) * 144 + 64 + 16 * q), nC);
            float fi[4], fc[4], rden[4]; int rows[4];
#pragma unroll
            for (int rg = 0; rg < 4; ++rg) { const int i = 16 * wm + 4 * q + rg;
                const float den_i = __shfl(nI[rg], lane & 48), qn_i = __shfl(nC[rg], lane & 48);
                const float bi = sc[i], mi = bi + sc[128 + i], mt_ = fmaxf(bi + m_st, mi);
                fc[rg] = __expf(bi + m_st - mt_); fi[rg] = __expf(mi - mt_);
                rden[rg] = 1.0f / fmaxf(fabsf(fc[rg] * qn_i + fi[rg] * den_i), __expf(-mt_)); rows[rg] = ((const LAS int*)sc)[192 + i]; }
#pragma unroll
            for (int t4 = 0; t4 < 4; ++t4) { const int et = 4 * wg + t4;
                f32x4 aI = (f32x4){0.f, 0.f, 0.f, 0.f}, aC = (f32x4){0.f, 0.f, 0.f, 0.f};
                aI = mfma16(sa0, ldsfrag(Vt + (16 * et + r16) * 144 + 16 * q), aI); aI = mfma16(sa1, ldsfrag(Vt + (16 * et + r16) * 144 + 64 + 16 * q), aI);
                aC = mfma16(qa0, ldsfrag(Ct + (16 * et + r16) * 144 + 16 * q), aC); aC = mfma16(qa1, ldsfrag(Ct + (16 * et + r16) * 144 + 64 + 16 * q), aC);
#pragma unroll
                for (int rg = 0; rg < 4; ++rg) H[(size_t)rows[rg] * 768 + h * 128 + 16 * et + r16] = (fc[rg] * aC[rg] + fi[rg] * aI[rg]) * rden[rg]; }
        }
        __syncthreads();
        {
            const bf16x8 kw0 = ldsfrag(KwT + (16 * wm + r16) * 144 + 16 * q), kw1 = ldsfrag(KwT + (16 * wm + r16) * 144 + 64 + 16 * q);
#pragma unroll
            for (int t5 = 0; t5 < 5; ++t5) { if (t5 < 4 || wg == 1) { const int et = 4 * wg + t5;
                accC[t5] = accC[t5] * a_old;
                accC[t5] = mfma16(kw0, ldsfrag(Vt + (16 * et + r16) * 144 + 16 * q), accC[t5]); accC[t5] = mfma16(kw1, ldsfrag(Vt + (16 * et + r16) * 144 + 64 + 16 * q), accC[t5]);
                *(LAS v2u*)(Ct + (16 * et + r16) * 144 + (16 * wm + 4 * q) * 2) = (v2u){pk2(accC[t5].x, accC[t5].y), pk2(accC[t5].z, accC[t5].w)}; } }
            m_st = m_new;
        }
        __syncthreads();
    }
}

constexpr int N_PHASES = 22; constexpr int S5_M1 = 192;
__global__ void __launch_bounds__(NWAVES * 64, 2) fwd_kernel(Args args) {
    extern __shared__ __attribute__((aligned(16))) unsigned char lds_raw[];
    LAS unsigned char* lds = (LAS unsigned char*)lds_raw;
    const int G = gridDim.x, bid = blockIdx.x, NGW = G * NWAVES;
    for (int u = threadIdx.x; u < (LDS_BYTES - LDSCTL_OFF) / 4; u += NWAVES * 64) ((LAS unsigned*)(lds + LDSCTL_OFF))[u] = 0u;
    __syncthreads();
    volatile LAS unsigned* MISC = (volatile LAS unsigned*)(lds + MISC_OFF);
    XcdBarrier bar; bar.bar = (unsigned*)(args.ws + WS_CTL) + CW_BAR; bar.x = 0; bar.st = nullptr;
#if !MK_PER_PHASE
    bar = xcd_barrier_post((unsigned*)(args.ws + WS_CTL) + CW_BAR, MISC + 8);
#endif
    const int lo = args.ph_lo, hi = args.ph_hi;
#define IN(k) (lo <= (k) && (k) < hi)
#define PH_IDS() int tid = threadIdx.x; asm volatile("" : "+v"(tid)); const int lane = tid & 63, wave = __builtin_amdgcn_readfirstlane(tid >> 6), gw = bid * NWAVES + wave; (void)lane; (void)gw
#define SEAM(k) do { if (IN(k) && IN((k) + 1)) xcd_barrier(bar); } while (0)

    if (IN(0)) { PH_IDS(); p0_prologue(args, lds, tid, lane, wave, bid, G); }
    SEAM(0);
    if (IN(1)) { PH_IDS(); rowpass<true, false, false, false, true>(args, gw, NGW, lane, MA, 0, 0, nullptr, 0, args.in[I_NMPRE], 0, 1); }
    SEAM(1);
#pragma unroll 1
    for (int l = 0; l < DEPTH; ++l) {
        const int pb = 2 + 10 * l;
        unsigned char* wl = args.ws + WS_W + (size_t)l * W_LAYER;
        const int Mrows = (l == DEPTH - 1) ? ML : MA;
        if (IN(pb + 0)) {
            pg8::Gemm g{(const pg8::bf16_t*)(args.ws + WS_ABUF), (const pg8::bf16_t*)wl, MA, N1, D}; pg8::StaticOrder S; S.init(MA, N1, G, bid);
            pg8::EpiProj E{(pg8::bf16_t*)(args.ws + WS_PBUF), LDP, (float*)(args.ws + WS_GBUF), GATE_TILE};
            pg8::gemm_phase<pg8::EpiProj, pg8::StaticOrder, true, true>(lds, g, S, E);
        }
        SEAM(pb + 0);
        if (IN(pb + 1)) {
            PH_IDS();
            if (bid < 48) mlstm_chunk_chain(args, lds, tid, lane, wave, l, bid);
            else { for (int u = bid - 48; u < S5_M1 + 864; u += G - 48) { if (u < S5_M1) s5_unit(args, lds, tid, l, u); else gdn_prep_unit(args, lds, tid, l, u - S5_M1); } }
        }
        SEAM(pb + 1);
        if (IN(pb + 2)) {
            PH_IDS();
            if (bid < 192) gdn_scan_unit(args, lds, tid, lane, wave, bid);
            else { for (int u = S5_M1 + bid - 192; u < 256; u += G - 192) s5_unit(args, lds, tid, l, u); }
        }
        SEAM(pb + 2);
        if (IN(pb + 3)) { PH_IDS(); finalize_rows(args, gw, NGW, lane, Mrows, l); }
        SEAM(pb + 3);
        if (IN(pb + 4)) {
            pg8::Gemm g{(const pg8::bf16_t*)(args.ws + WS_Y5), (const pg8::bf16_t*)(wl + WGLU_OFF), Mrows, 512, 512}; pg8::StaticOrder S; S.init(Mrows, 512, G, bid);
            pg8::EpiGlu E{(const pg8::bf16_t*)(args.ws + WS_Y5), 512, (pg8::bf16_t*)(args.ws + WS_MIX), D, args.in[I_GLUB] + l * 512};
            pg8::gemm_phase<pg8::EpiGlu, pg8::StaticOrder, true, true>(lds, g, S, E);
        }
        SEAM(pb + 4);
        if (IN(pb + 5)) {
            pg8::Gemm g{(const pg8::bf16_t*)(args.ws + WS_MIX), (const pg8::bf16_t*)(wl + WO_OFF), Mrows, D, D}; pg8::StaticOrder S; S.init(Mrows, D, G, bid);
            pg8::EpiF32 E{(float*)(args.ws + WS_R), D};
            pg8::gemm_phase<pg8::EpiF32, pg8::StaticOrder, true, true>(lds, g, S, E);
        }
        SEAM(pb + 5);
        if (IN(pb + 6)) {
            PH_IDS();
            if (l == 0) rowpass<true, true, true, false, true>(args, gw, NGW, lane, Mrows, l, 2, args.in[I_NMPOST] + l * D, l, args.in[I_NFPRE] + l * D, 3, 4);
            else rowpass<false, true, true, false, true>(args, gw, NGW, lane, Mrows, l, 2, args.in[I_NMPOST] + l * D, l, args.in[I_NFPRE] + l * D, 3, 4);
        }
        SEAM(pb + 6);
        if (IN(pb + 7)) {
            pg8::Gemm g{(const pg8::bf16_t*)(args.ws + WS_ABUF), (const pg8::bf16_t*)(wl + WGU_OFF), Mrows, 2 * FF, D}; pg8::StaticOrder S; S.init(Mrows, 2 * FF, G, bid);
            pg8::EpiSwiGLU E{(pg8::bf16_t*)(args.ws + WS_PBUF), FF};
            pg8::gemm_phase<pg8::EpiSwiGLU, pg8::StaticOrder, true, true>(lds, g, S, E);
        }
        SEAM(pb + 7);
        if (IN(pb + 8)) {
            pg8::Gemm g{(const pg8::bf16_t*)(args.ws + WS_PBUF), (const pg8::bf16_t*)(wl + WD_OFF), Mrows, D, FF}; pg8::StaticOrder S; S.init(Mrows, D, G, bid);
            pg8::EpiF32 E{(float*)(args.ws + WS_R), D};
            pg8::gemm_phase<pg8::EpiF32, pg8::StaticOrder, true, true>(lds, g, S, E);
        }
        SEAM(pb + 8);
        if (IN(pb + 9)) {
            PH_IDS();
            if (l < DEPTH - 1) rowpass<false, true, true, false, true>(args, gw, NGW, lane, Mrows, l, 5, args.in[I_NFPOST] + l * D, l + 1, args.in[I_NMPRE] + (l + 1) * D, 0, 1);
            else rowpass<false, true, false, true, false>(args, gw, NGW, lane, Mrows, l, 5, args.in[I_NFPOST] + l * D, 0, nullptr, 0, 0);
        }
        SEAM(pb + 9);
    }
#undef IN
#undef SEAM
}

extern "C" void kernel_launch(void* const* d_in, const int* in_sizes, int n_in, void* d_out, int out_size, void* d_ws, size_t ws_size, hipStream_t stream) {
    static int grid = 0;
    if (grid == 0) {
        if (n_in != N_IN || in_sizes[0] != ML * D || out_size != ML * D || ws_size < WS_END) {
            fprintf(stderr, "kernel_launch: unexpected shapes (n_in %d, in0 %d, out %d, ws %zu, need %zu); nothing launched\n", n_in, n_in > 0 ? in_sizes[0] : -1, out_size, ws_size, (size_t)WS_END); grid = -1; return; }
        int dev = 0, cus = 0;
        if (hipGetDevice(&dev) != hipSuccess || hipDeviceGetAttribute(&cus, hipDeviceAttributeMultiprocessorCount, dev) != hipSuccess) { grid = -1; return; }
        if (hipFuncSetAttribute((const void*)fwd_kernel, hipFuncAttributeMaxDynamicSharedMemorySize, LDS_BYTES) != hipSuccess) { fprintf(stderr, "kernel_launch: hipFuncSetAttribute failed\n"); grid = -1; return; }
        int per_cu = 0;
        if (hipOccupancyMaxActiveBlocksPerMultiprocessor(&per_cu, (const void*)fwd_kernel, NWAVES * 64, LDS_BYTES) != hipSuccess || per_cu < 1)
            fprintf(stderr, "kernel_launch: occupancy query reports %d workgroups per CU\n", per_cu);
        (void)hipGetLastError();
        grid = cus;
        if (grid != 256) fprintf(stderr, "kernel_launch: %d CUs (built for 256)\n", grid);
    }
    if (grid < 0) return;
    (void)hipMemsetAsync((char*)d_ws + WS_CTL, 0, CTL_ZERO_BYTES, stream);
    Args a{};
    for (int i = 0; i < N_IN; ++i) a.in[i] = (const float*)d_in[i];
    a.out = (float*)d_out; a.ws = (unsigned char*)d_ws;
#if MK_PER_PHASE
    for (int ph = 0; ph < N_PHASES; ++ph) { a.ph_lo = ph; a.ph_hi = ph + 1; a.li = ph; hipLaunchKernelGGL(fwd_kernel, dim3(grid), dim3(NWAVES * 64), LDS_BYTES, stream, a); }
#else
    a.ph_lo = 0; a.ph_hi = N_PHASES; a.li = 0;
    hipLaunchKernelGGL(fwd_kernel, dim3(grid), dim3(NWAVES * 64), LDS_BYTES, stream, a);
#endif
}
```

```cpp
#include <hip/hip_runtime.h>
#include <cstdio>
#include <cstdint>
namespace pg8 {
#define PG8_LAS __attribute__((address_space(3)))
typedef unsigned short bf16_t;
typedef short bf16x8 __attribute__((ext_vector_type(8)));
typedef float f32x4 __attribute__((ext_vector_type(4)));
typedef unsigned u32x4 __attribute__((ext_vector_type(4)));
constexpr int BM = 256, BK = 64, HALF = 128, HTB = HALF * BK * 2  , STAGE_BYTES = 8 * HTB, NXCD = 8, WGM = 8;

__host__ __device__ __forceinline__ int lds_byte(int r, int c) { const int st = (r >> 4) * 2 + (c >> 5), rr = r & 15, cc = c & 31, ob = rr * 64 + cc * 2; return st * 1024 + (ob ^ (((ob >> 9) & 1) << 5)); }
__host__ __device__ __forceinline__ void stage_rc(int b, int& R, int& C) { const int st = b / 1024, sb = b % 1024, swz = sb ^ (((sb >> 9) & 1) << 5); R = (st >> 1) * 16 + swz / 64; C = (st & 1) * 32 + (swz % 64) / 2; }
__host__ __device__ __forceinline__ int perm32(int rho) { const int n = rho >> 4, i = rho & 15; return 8 * (i >> 2) + 4 * n + (i & 3); }

struct Unit { int pm, pn; };
struct Gemm { const bf16_t* A; const bf16_t* Bt; int M, N, K; };

struct StaticOrder {
    int nM, nN, nwg, G, c;
    __host__ __device__ void init(int M, int N, int G_, int c_) { nM = M / BM; nN = N / BM; nwg = nM * nN; G = G_; c = c_; }
    __host__ __device__ bool next(int i, Unit& u) const {
        const long L = (long)i * G + c; if (L >= nwg) return false;
        int wgid = (int)L; { const int q = nwg / NXCD, r = nwg % NXCD, xcd = wgid % NXCD, off = wgid / NXCD; wgid = (xcd < r ? xcd * (q + 1) : r * (q + 1) + (xcd - r) * q) + off; }
        const int nig = WGM * nN, gid = wgid / nig, fm = gid * WGM, gsz = (nM - fm) < WGM ? (nM - fm) : WGM;
        u.pm = fm + ((wgid % nig) % gsz); u.pn = (wgid % nig) / gsz; return true;
    }
    __device__ __forceinline__ void a_ready(const Unit&) const {}
    __device__ __forceinline__ void done(const Unit&) const {}
};

__device__ __forceinline__ unsigned cvt_pk_bf16(float lo, float hi) { unsigned r; asm volatile("v_cvt_pk_bf16_f32 %0, %1, %2" : "=v"(r) : "v"(lo), "v"(hi)); return r; }
__device__ __forceinline__ float bf_lo(unsigned w) { return __uint_as_float(w << 16); }
__device__ __forceinline__ float bf_hi(unsigned w) { return __uint_as_float(w & 0xffff0000u); }
__device__ __forceinline__ float sigmoidf_(float x) { return 1.0f / (1.0f + __expf(-x)); }

struct EpiF32 {
    static constexpr bool PERM = false, AFTER_DRAIN = false;
    float* C; int ldc;
    __device__ __forceinline__ void operator()(const f32x4 (&acc)[2][2][4][2], const Unit& u, int wr, int wc, int fr, int fq) const {
        const int row0 = u.pm * BM + wr * 64 + fr, col0 = u.pn * BM + wc * 32 + 4 * fq;
#pragma unroll
        for (int ai = 0; ai < 2; ++ai)
#pragma unroll
            for (int m = 0; m < 4; ++m) { float* rowp = C + (size_t)(row0 + ai * HALF + m * 16) * ldc + col0;
#pragma unroll
                for (int bj = 0; bj < 2; ++bj)
#pragma unroll
                    for (int n = 0; n < 2; ++n) *(f32x4*)(rowp + bj * HALF + n * 16) = acc[ai][bj][m][n]; }
    }
};
struct EpiProj {
    static constexpr bool PERM = true, AFTER_DRAIN = false;
    bf16_t* P; int ldp; float* G; int gate_tile;
    __device__ __forceinline__ void operator()(const f32x4 (&acc)[2][2][4][2], const Unit& u, int wr, int wc, int fr, int fq) const {
        const int row0 = u.pm * BM + wr * 64 + fr;
        if (u.pn != gate_tile) {
            const int col0 = u.pn * BM + wc * 32 + 8 * fq;
#pragma unroll
            for (int ai = 0; ai < 2; ++ai)
#pragma unroll
                for (int m = 0; m < 4; ++m) { bf16_t* rowp = P + (size_t)(row0 + ai * HALF + m * 16) * ldp + col0;
#pragma unroll
                    for (int bj = 0; bj < 2; ++bj) { const f32x4 v0 = acc[ai][bj][m][0], v1 = acc[ai][bj][m][1];
                        u32x4 w; w.x = cvt_pk_bf16(v0[0], v0[1]); w.y = cvt_pk_bf16(v0[2], v0[3]); w.z = cvt_pk_bf16(v1[0], v1[1]); w.w = cvt_pk_bf16(v1[2], v1[3]);
                        *(u32x4*)(rowp + bj * HALF) = w; } }
        } else {
            const int col0 = wc * 32 + 8 * fq;
#pragma unroll
            for (int ai = 0; ai < 2; ++ai)
#pragma unroll
                for (int m = 0; m < 4; ++m) { float* rowp = G + (size_t)(row0 + ai * HALF + m * 16) * 128 + col0;
                    *(f32x4*)(rowp) = acc[ai][0][m][0]; *(f32x4*)(rowp + 4) = acc[ai][0][m][1]; }
        }
    }
};
struct EpiSwiGLU {
    static constexpr bool PERM = true, AFTER_DRAIN = false;
    bf16_t* O; int ldc;
    __device__ __forceinline__ void operator()(const f32x4 (&acc)[2][2][4][2], const Unit& u, int wr, int wc, int fr, int fq) const {
        const int row0 = u.pm * BM + wr * 64 + fr, col0 = u.pn * HALF + wc * 32 + 8 * fq;
#pragma unroll
        for (int ai = 0; ai < 2; ++ai)
#pragma unroll
            for (int m = 0; m < 4; ++m) { bf16_t* rowp = O + (size_t)(row0 + ai * HALF + m * 16) * ldc + col0;
                float r[8];
#pragma unroll
                for (int n = 0; n < 2; ++n)
#pragma unroll
                    for (int j = 0; j < 4; ++j) { const float g = acc[ai][0][m][n][j], up = acc[ai][1][m][n][j]; r[n * 4 + j] = g * sigmoidf_(g) * up; }
                u32x4 w; w.x = cvt_pk_bf16(r[0], r[1]); w.y = cvt_pk_bf16(r[2], r[3]); w.z = cvt_pk_bf16(r[4], r[5]); w.w = cvt_pk_bf16(r[6], r[7]);
                *(u32x4*)rowp = w; }
    }
};
struct EpiGlu {
    static constexpr bool PERM = true, AFTER_DRAIN = false;
    const bf16_t* Y; int ldy; bf16_t* O; int ldo; const float* bias;
    __device__ __forceinline__ void operator()(const f32x4 (&acc)[2][2][4][2], const Unit& u, int wr, int wc, int fr, int fq) const {
        const int row0 = u.pm * BM + wr * 64 + fr, col0 = u.pn * BM + wc * 32 + 8 * fq;
        f32x4 bv[2][2];
#pragma unroll
        for (int bj = 0; bj < 2; ++bj)
#pragma unroll
            for (int n = 0; n < 2; ++n) bv[bj][n] = *(const f32x4*)(bias + col0 + bj * HALF + 4 * n);
#pragma unroll
        for (int ai = 0; ai < 2; ++ai)
#pragma unroll
            for (int m = 0; m < 4; ++m) { const size_t row = (size_t)(row0 + ai * HALF + m * 16);
#pragma unroll
                for (int bj = 0; bj < 2; ++bj) {
                    const u32x4 yv = *(const u32x4*)(Y + row * ldy + col0 + bj * HALF);
                    const f32x4 v0 = acc[ai][bj][m][0] + bv[bj][0], v1 = acc[ai][bj][m][1] + bv[bj][1];
                    u32x4 w;
                    w.x = cvt_pk_bf16(bf_lo(yv.x) * sigmoidf_(v0[0]), bf_hi(yv.x) * sigmoidf_(v0[1]));
                    w.y = cvt_pk_bf16(bf_lo(yv.y) * sigmoidf_(v0[2]), bf_hi(yv.y) * sigmoidf_(v0[3]));
                    w.z = cvt_pk_bf16(bf_lo(yv.z) * sigmoidf_(v1[0]), bf_hi(yv.z) * sigmoidf_(v1[1]));
                    w.w = cvt_pk_bf16(bf_lo(yv.w) * sigmoidf_(v1[2]), bf_hi(yv.w) * sigmoidf_(v1[3]));
                    *(u32x4*)(O + row * ldo + col0 + bj * HALF) = w; } }
    }
};

template <class Epi, class Sched, bool ALIGN_EPI = false, bool SP2 = false>
__device__ __forceinline__ void gemm_phase(PG8_LAS unsigned char* lds, const Gemm g, const Sched& S, const Epi& E) {
    int tid_ = threadIdx.x; asm volatile("" : "+v"(tid_));
    const int tid = tid_, wid = __builtin_amdgcn_readfirstlane(tid >> 6), lane = tid & 63, wr = wid >> 2, wc = wid & 3, fr = lane & 15, fq = lane >> 4;
    const int K = g.K, nt = K / BK;
    unsigned voffA[2], voffB[2];
#pragma unroll
    for (int i = 0; i < 2; ++i) { int R, C; stage_rc(tid * 16 + i * 8192, R, C); const int Rb = Epi::PERM ? ((R & ~31) + perm32(R & 31)) : R;
        voffA[i] = (unsigned)(R * K + C) * 2u; voffB[i] = (unsigned)(Rb * K + C) * 2u; }
    const size_t kstep = (size_t)(BK * 2);
    const size_t hstep = (size_t)HALF * K * 2;
    const size_t tstep = 2 * hstep;
    const unsigned ldsw = (unsigned)wid * 1024u;
    const int aoff = lds_byte(wr * 64 + fr, fq * 8), boff = lds_byte(wc * 32 + fr, fq * 8);
#define PG8_SA(b, h) (((b) * 2 + (h)) * HTB)
#define PG8_SB(b, h) ((4 + (b) * 2 + (h)) * HTB)
#define PG8_STAGE(bufoff, gbase, voff) do { _Pragma("unroll") for (int _i = 0; _i < 2; ++_i) \
        __builtin_amdgcn_global_load_lds((const unsigned*)((const char*)(gbase) + (voff)[_i]), (PG8_LAS unsigned*)(lds + (bufoff) + ldsw + _i * 8192), 16, 0, 0); } while (0)
#define PG8_LDA(dst, b, h) do { _Pragma("unroll") for (int m = 0; m < 4; ++m) _Pragma("unroll") for (int k = 0; k < 2; ++k) dst[m][k] = *(const PG8_LAS bf16x8*)(lds + PG8_SA(b, h) + aoff + m * 2048 + k * 1024); } while (0)
#define PG8_LDB(dst, b, h) do { _Pragma("unroll") for (int n = 0; n < 2; ++n) _Pragma("unroll") for (int k = 0; k < 2; ++k) dst[n][k] = *(const PG8_LAS bf16x8*)(lds + PG8_SB(b, h) + boff + n * 2048 + k * 1024); } while (0)
#define PG8_MMA(ai, bj, At, Bt) do { __builtin_amdgcn_s_setprio(1); _Pragma("unroll") for (int m = 0; m < 4; ++m) _Pragma("unroll") for (int n = 0; n < 2; ++n) _Pragma("unroll") for (int k = 0; k < 2; ++k) \
        acc[ai][bj][m][n] = __builtin_amdgcn_mfma_f32_16x16x32_bf16(Bt[n][k], At[m][k], acc[ai][bj][m][n], 0, 0, 0); __builtin_amdgcn_s_setprio(0); } while (0)
#define PG8_WAIT_V(n) asm volatile("s_waitcnt vmcnt(" #n ")" ::: "memory")
#define PG8_WAIT_L(n) asm volatile("s_waitcnt lgkmcnt(" #n ")" ::: "memory")
#define PG8_BAR __builtin_amdgcn_s_barrier()
#define PG8_SCHED __builtin_amdgcn_sched_barrier(0)
    Unit cur, nxt; int ui = 0;
    if (!S.next(0, cur)) return;
    f32x4 acc[2][2][4][2];
#pragma unroll
    for (int a = 0; a < 2; ++a)
#pragma unroll
        for (int b = 0; b < 2; ++b)
#pragma unroll
            for (int m = 0; m < 4; ++m)
#pragma unroll
                for (int n = 0; n < 2; ++n) acc[a][b][m][n] = (f32x4){0.f, 0.f, 0.f, 0.f};
    bf16x8 At[4][2], B0[2][2], B1[2][2];
    const char* cA = (const char*)g.A + (size_t)cur.pm * tstep; const char* cB = (const char*)g.Bt + (size_t)cur.pn * tstep;
    S.a_ready(cur);
    if constexpr (SP2) {
        PG8_STAGE(PG8_SB(0, 0), cB, voffB); PG8_STAGE(PG8_SB(0, 1), cB + hstep, voffB); PG8_STAGE(PG8_SA(0, 0), cA, voffA); PG8_STAGE(PG8_SA(0, 1), cA + hstep, voffA);
        if (wr == 1) PG8_BAR;
        PG8_WAIT_V(2); PG8_BAR;
        PG8_STAGE(PG8_SB(1, 0), cB + kstep, voffB); PG8_STAGE(PG8_SA(1, 0), cA + kstep, voffA); PG8_STAGE(PG8_SB(1, 1), cB + hstep + kstep, voffB);
        PG8_WAIT_V(6); PG8_BAR;
    } else {
        PG8_STAGE(PG8_SB(0, 0), cB, voffB); PG8_STAGE(PG8_SA(0, 0), cA, voffA); PG8_STAGE(PG8_SB(0, 1), cB + hstep, voffB); PG8_STAGE(PG8_SA(0, 1), cA + hstep, voffA);
        if (wr == 1) PG8_BAR;
        PG8_WAIT_V(4); PG8_BAR;
        PG8_STAGE(PG8_SB(1, 0), cB + kstep, voffB); PG8_STAGE(PG8_SA(1, 0), cA + kstep, voffA); PG8_STAGE(PG8_SB(1, 1), cB + hstep + kstep, voffB);
        PG8_WAIT_V(6); PG8_BAR;
    }
    for (;;) {
        const bool has_next = S.next(ui + 1, nxt);
        const char* nA = has_next ? (const char*)g.A + (size_t)nxt.pm * tstep : cA; const char* nB = has_next ? (const char*)g.Bt + (size_t)nxt.pn * tstep : cB;
        for (int t = 0; t < nt; t += 2) {
            const bool last = (t == nt - 2);
            const char* a1 = cA + (size_t)(t + 1) * kstep;
            const char* a2 = last ? nA : cA + (size_t)(t + 2) * kstep; const char* b2 = last ? nB : cB + (size_t)(t + 2) * kstep;
            const char* a3 = a2 + kstep; const char* b3 = b2 + kstep;
            if (last && has_next) S.a_ready(nxt);
            if constexpr (SP2) {
            PG8_LDB(B0, 0, 0); PG8_LDB(B1, 0, 1); PG8_SCHED; PG8_LDA(At, 0, 0); PG8_STAGE(PG8_SA(1, 1), a1 + hstep, voffA);
            PG8_WAIT_V(8); PG8_WAIT_L(0); PG8_BAR; PG8_MMA(0, 0, At, B0); PG8_MMA(0, 1, At, B1); PG8_BAR; PG8_SCHED;
            PG8_LDA(At, 0, 1); PG8_STAGE(PG8_SB(0, 0), b2, voffB); PG8_STAGE(PG8_SB(0, 1), b2 + hstep, voffB); PG8_STAGE(PG8_SA(0, 0), a2, voffA);
            PG8_WAIT_V(8); PG8_WAIT_L(0); PG8_BAR; PG8_MMA(1, 0, At, B0); PG8_MMA(1, 1, At, B1); PG8_BAR; PG8_SCHED;
            PG8_LDB(B0, 1, 0); PG8_LDB(B1, 1, 1); PG8_SCHED; PG8_LDA(At, 1, 0); PG8_STAGE(PG8_SA(0, 1), a2 + hstep, voffA);
            PG8_WAIT_V(8); PG8_WAIT_L(0); PG8_BAR; PG8_MMA(0, 0, At, B0); PG8_MMA(0, 1, At, B1); PG8_BAR; PG8_SCHED;
            PG8_LDA(At, 1, 1); PG8_STAGE(PG8_SB(1, 0), b3, voffB); PG8_STAGE(PG8_SB(1, 1), b3 + hstep, voffB); PG8_STAGE(PG8_SA(1, 0), a3, voffA);
            PG8_WAIT_V(8); PG8_WAIT_L(0); PG8_BAR; PG8_MMA(1, 0, At, B0); PG8_MMA(1, 1, At, B1); PG8_BAR; PG8_SCHED;
            } else {
            PG8_LDB(B0, 0, 0); PG8_SCHED; PG8_LDA(At, 0, 0); PG8_STAGE(PG8_SA(1, 1), a1 + hstep, voffA);
            PG8_WAIT_L(8); PG8_BAR; PG8_WAIT_L(0); PG8_MMA(0, 0, At, B0); PG8_BAR; PG8_SCHED;
            PG8_LDB(B1, 0, 1); PG8_STAGE(PG8_SB(0, 0), b2, voffB);
            PG8_BAR; PG8_WAIT_L(0); PG8_MMA(0, 1, At, B1); PG8_BAR;
            PG8_LDA(At, 0, 1); PG8_STAGE(PG8_SA(0, 0), a2, voffA);
            PG8_BAR; PG8_WAIT_L(0); PG8_MMA(1, 0, At, B0); PG8_BAR; PG8_SCHED;
            PG8_STAGE(PG8_SB(0, 1), b2 + hstep, voffB);
            PG8_WAIT_V(6); PG8_BAR; PG8_MMA(1, 1, At, B1); PG8_BAR;
            PG8_LDB(B0, 1, 0); PG8_SCHED; PG8_LDA(At, 1, 0); PG8_STAGE(PG8_SA(0, 1), a2 + hstep, voffA);
            PG8_WAIT_L(8); PG8_BAR; PG8_WAIT_L(0); PG8_MMA(0, 0, At, B0); PG8_BAR; PG8_SCHED;
            PG8_LDB(B1, 1, 1); PG8_STAGE(PG8_SB(1, 0), b3, voffB);
            PG8_BAR; PG8_WAIT_L(0); PG8_MMA(0, 1, At, B1); PG8_BAR;
            PG8_LDA(At, 1, 1); PG8_STAGE(PG8_SA(1, 0), a3, voffA);
            PG8_BAR; PG8_WAIT_L(0); PG8_MMA(1, 0, At, B0); PG8_BAR; PG8_SCHED;
            PG8_STAGE(PG8_SB(1, 1), b3 + hstep, voffB);
            PG8_WAIT_V(6); PG8_BAR; PG8_MMA(1, 1, At, B1); PG8_BAR;
            }
        }
        if constexpr (ALIGN_EPI) { if (wr == 0) PG8_BAR; }
        if constexpr (!Epi::AFTER_DRAIN) { E(acc, cur, wr, wc, fr, fq); S.done(cur); }
        if (!has_next) break;
#pragma unroll
        for (int a = 0; a < 2; ++a)
#pragma unroll
            for (int b = 0; b < 2; ++b)
#pragma unroll
                for (int m = 0; m < 4; ++m)
#pragma unroll
                    for (int n = 0; n < 2; ++n) acc[a][b][m][n] = (f32x4){0.f, 0.f, 0.f, 0.f};
        cur = nxt; cA = nA; cB = nB; ++ui;
        if constexpr (ALIGN_EPI) { if (wr == 1) PG8_BAR; }
    }
    PG8_WAIT_V(0);
    if constexpr (!ALIGN_EPI) { if (wr == 0) PG8_BAR; }
    PG8_BAR;
    if constexpr (Epi::AFTER_DRAIN) { E.fused(acc, cur, wr, wc, fr, fq, lds, wid, lane); S.done(cur); }
#undef PG8_SA
#undef PG8_SB
#undef PG8_STAGE
#undef PG8_LDA
#undef PG8_LDB
#undef PG8_MMA
#undef PG8_WAIT_V
#undef PG8_WAIT_L
#undef PG8_BAR
#undef PG8_SCHED
}
}

#ifndef MK_PER_PHASE
#define MK_PER_PHASE 0
#endif
constexpr int NWAVES = 8;
constexpr int NB = 4, TL = 2048, TC = 256, D = 2048, DEPTH = 2;
constexpr int ML = NB * TL, MC = NB * TC, MA = ML + MC;
constexpr int NPROJ = 5936, N1 = 6144, LDP = 5888, GATE_TILE = 23;
constexpr int FF = 5632;
constexpr float EPS = 1e-6f;
constexpr int PC_U = 0, PC_GQ = 512, PC_GK = 1280, PC_GV = 2048, PC_GZ = 2816, PC_MQ = 3584, PC_MK = 3968, PC_MV = 4352, PC_MO = 5120;
constexpr int GC_A = 0, GC_B = 12, GC_I = 24, GC_F = 36;
enum { I_X = 0, I_C, I_CTX, I_CCTX, I_ADAW, I_ADAB, I_NMPRE, I_NMPOST, I_NFPRE, I_NFPOST, I_WIN, I_WOUT, I_LAMRE, I_LAMIM, I_LOGDT, I_BRE, I_BIM, I_CRE, I_CIM, I_S5D,
       I_GLUW, I_GLUB, I_CONVW, I_ALOG, I_DTB, I_GNORM, I_IB, I_FB, I_MNORM, I_WG, I_WU, I_WD, N_IN };

constexpr size_t MiB = 1u << 20;
constexpr size_t WS_CTL = 0, CTL_ZERO_BYTES = 64 * 1024;
constexpr size_t WS_MODS = 1 * MiB;
constexpr size_t WS_W = 2 * MiB, W_LAYER = 99 * MiB;
constexpr size_t WO_OFF = 24 * MiB, WGU_OFF = 32 * MiB, WD_OFF = 76 * MiB, WGLU_OFF = 98 * MiB;
constexpr size_t WS_XBUF = WS_W + 2 * W_LAYER;
constexpr size_t WS_PBUF = WS_XBUF + 72 * MiB;
constexpr size_t WS_GBUF = WS_PBUF + 104 * MiB;
constexpr size_t WS_YS5 = WS_GBUF + 5 * MiB;
constexpr size_t WS_OG = WS_YS5 + 36 * MiB;
constexpr size_t WS_HM = WS_OG + 54 * MiB;
constexpr size_t WS_R = WS_HM + 54 * MiB;
constexpr size_t WS_ABUF = WS_R + 72 * MiB;
constexpr size_t WS_MIX = WS_ABUF + 36 * MiB;
constexpr size_t WS_Y5 = WS_MIX + 36 * MiB;
constexpr size_t WS_END = WS_Y5 + 9 * MiB;
constexpr size_t WS_S5T = WS_END;
constexpr size_t WS_TOTAL = WS_S5T + 72 * MiB;
constexpr size_t WS_GDN = WS_R;
static_assert(WS_GDN + (size_t)1728 * 90368 <= WS_END, "GDN chunk blocks fit their overlay");
static_assert(WS_TOTAL <= 768 * MiB, "workspace map");
constexpr int CW_TMO = 0, CW_BAR = 4096;

constexpr int RING_BYTES = 131072, LDS_BYTES = 147456, LDSCTL_OFF = LDS_BYTES - 512, MISC_OFF = LDSCTL_OFF + 320;

#define GAS __attribute__((address_space(1)))
#define LAS __attribute__((address_space(3)))
typedef unsigned short bf16;
typedef unsigned v4u __attribute__((ext_vector_type(4)));
typedef unsigned v2u __attribute__((ext_vector_type(2)));
typedef float f32x4 __attribute__((ext_vector_type(4)));
typedef float f32x2 __attribute__((ext_vector_type(2)));
typedef GAS unsigned gu32;
#define RLX_AGENT __ATOMIC_RELAXED, __HIP_MEMORY_SCOPE_AGENT
#define LDS_WAIT() asm volatile("s_waitcnt lgkmcnt(0)" ::: "memory")
#define VM_WAIT() asm volatile("s_waitcnt vmcnt(0)" ::: "memory")
__device__ __forceinline__ unsigned f2bf(float f) { unsigned u = __builtin_bit_cast(unsigned, f); return (u + 0x7fffu + ((u >> 16) & 1u)) >> 16; }
__device__ __forceinline__ unsigned pk2(float lo, float hi) { return f2bf(lo) | (f2bf(hi) << 16); }
__device__ __forceinline__ float bflo(unsigned w) { return __uint_as_float(w << 16); }
__device__ __forceinline__ float bfhi(unsigned w) { return __uint_as_float(w & 0xffff0000u); }
__device__ __forceinline__ float sigm(float x) { return 1.0f / (1.0f + __expf(-x)); }
__device__ __forceinline__ float siluf(float x) { return x * sigm(x); }
__device__ __forceinline__ float softplusf(float x) { return x > 20.f ? x : log1pf(expf(x)); }
__device__ __forceinline__ float logsigmoidf(float x) { return fminf(x, 0.f) - log1pf(expf(-fabsf(x))); }
__device__ __forceinline__ float gelu_tanh(float x) { return 0.5f * x * (1.0f + tanhf(0.7978845608028654f * (x + 0.044715f * x * x * x))); }
__device__ __forceinline__ float wave_sum(float v) {
#pragma unroll
    for (int o = 1; o < 64; o <<= 1) v += __shfl_xor(v, o);
    return v;
}
#define XB_TMO      128
#define XB_XCNT(j)  (256  + 64 * (j))
#define XB_XSUB(j)  (1280 + 64 * (j))
#define XB_XGEN(j)  (2304 + 64 * (j))
#define XB_TOP      3328
#define XB_TOPGEN   3392
#define XCD_BAR_WORDS 3456
#define XB_SPIN_CAP (1u << 18)

__device__ __forceinline__ unsigned xb_ld(unsigned* p)              { return __hip_atomic_load(p, __ATOMIC_RELAXED, __HIP_MEMORY_SCOPE_AGENT); }
__device__ __forceinline__ unsigned xb_add(unsigned* p, unsigned v) { return __hip_atomic_fetch_add(p, v, __ATOMIC_RELAXED, __HIP_MEMORY_SCOPE_AGENT); }
__device__ __forceinline__ unsigned xb_xcc_id() { return (unsigned)__builtin_amdgcn_s_getreg((3 << 11) | 20) & 0xFu; }
#define XB_SPIN(cond, bar) do { unsigned _sp = 0; while (cond) { __builtin_amdgcn_s_sleep(1); \
    if ((++_sp & 255u) == 0u) { if (xb_ld(&(bar)[XB_TMO])) break; if (_sp > XB_SPIN_CAP) { atomicAdd(&(bar)[XB_TMO], 1u); break; } } } } while (0)

struct XcdBarrier {
    unsigned* bar; unsigned x;
    volatile LAS unsigned* st;
};

__device__ __forceinline__ XcdBarrier xcd_barrier_post(unsigned* bar, volatile LAS unsigned* st) {
    XcdBarrier b; b.bar = bar; b.x = xb_xcc_id(); b.st = st;
    if (threadIdx.x == 0) (void)xb_add(&bar[XB_XCNT(b.x)], 1u);
    return b;
}
__device__ __forceinline__ void xcd_barrier_complete(unsigned* bar, unsigned x, unsigned& nloc, unsigned& nx) {
    const unsigned G = gridDim.x * gridDim.y * gridDim.z;
    unsigned sum, cnt, mine, sp = 0u;
    for (;;) {
        sum = 0u; cnt = 0u; mine = 0u;
#pragma unroll
        for (unsigned j = 0; j < 16; ++j) { const unsigned c = xb_ld(&bar[XB_XCNT(j)]); sum += c; cnt += (c > 0u) ? 1u : 0u; mine = (j == x) ? c : mine; }
        if (sum == G) break;
        __builtin_amdgcn_s_sleep(1);
        if ((++sp & 255u) == 0u) { if (xb_ld(&bar[XB_TMO])) break; if (sp > XB_SPIN_CAP) { atomicAdd(&bar[XB_TMO], 1u); break; } }
    }
    nloc = mine > 0u ? mine : 1u; nx = cnt > 0u ? cnt : 1u;
}

__device__ __forceinline__ void xcd_barrier(const XcdBarrier& b) {
    asm volatile("s_waitcnt vmcnt(0)" ::: "memory");
    __syncthreads();
    if (threadIdx.x == 0) {
        unsigned* bar = b.bar;
        __builtin_amdgcn_s_waitcnt(0);
        unsigned nloc = b.st[0], nx = b.st[1];
        if (nloc == 0u) { xcd_barrier_complete(bar, b.x, nloc, nx); b.st[0] = nloc; b.st[1] = nx; }
        const unsigned old = xb_add(&bar[XB_XSUB(b.x)], 1u);
        const unsigned gen = old / nloc;
        if (old + 1u == (gen + 1u) * nloc) {
            __builtin_amdgcn_fence(__ATOMIC_RELEASE, "agent");
            asm volatile("s_waitcnt vmcnt(0)" ::: "memory");
            const unsigned og = xb_add(&bar[XB_TOP], 1u);
            const unsigned tg = og / nx;
            if (og + 1u == (tg + 1u) * nx) xb_add(&bar[XB_TOPGEN], 1u);
            else XB_SPIN(xb_ld(&bar[XB_TOPGEN]) == tg, bar);
            __builtin_amdgcn_fence(__ATOMIC_ACQUIRE, "agent");
            xb_add(&bar[XB_XGEN(b.x)], 1u);
            asm volatile("s_waitcnt vmcnt(0)" ::: "memory");
        } else {
            XB_SPIN(xb_ld(&bar[XB_XGEN(b.x)]) == gen, bar);
            __builtin_amdgcn_fence(__ATOMIC_ACQUIRE, "agent");
            asm volatile("s_waitcnt vmcnt(0)" ::: "memory");
        }
    }
    __syncthreads();
}

struct Args { const float* in[N_IN]; float* out; unsigned char* ws; int ph_lo, ph_hi, li, pad; };

__device__ __forceinline__ int scan_row(int b, int c, int i, int d) {
    const bool isc = c < 4; const int T = isc ? TC : TL, pos = (isc ? c : c - 4) * 64 + i, t = d ? T - 1 - pos : pos;
    return isc ? ML + b * TC + t : b * TL + t;
}
__device__ __forceinline__ void s5_tables_unit(const Args& a, LAS unsigned char* lds, int tid_in, int unit);
template <int MODE> __device__ __forceinline__ int dst_row(int n) {
    if (MODE == 1) return n < 3584 ? n : (n < 3608 ? 5888 + (n - 3584) : (n < 5912 ? n - 24 : n));
    if (MODE == 2) return 256 * (n >> 7) + (n & 127);
    if (MODE == 3) return 256 * (n >> 7) + 128 + (n & 127);
    return n;
}
template <int MODE> __device__ __forceinline__ void transpose_item(const float* W, int K, int N, bf16* WT, LAS float* scr, int item, int lane) {
    const int nblk = (N + 31) / 32, kb = item / nblk, nb = item % nblk, k0 = 64 * kb, n0 = 32 * nb;
    const int nn = n0 + (lane & 31);
#pragma unroll
    for (int i = 0; i < 32; ++i) { const int kk = 2 * i + (lane >> 5); scr[kk * 33 + (lane & 31)] = nn < N ? W[(size_t)(k0 + kk) * N + nn] : 0.f; }
    LDS_WAIT(); asm volatile("" ::: "memory");
    const int c = lane & 7;
#pragma unroll
    for (int j = 0; j < 4; ++j) { const int nl = (lane >> 3) + 8 * j, n = n0 + nl; const LAS float* s = scr + (8 * c) * 33 + nl;
        v4u o; o.x = pk2(s[0 * 33], s[1 * 33]); o.y = pk2(s[2 * 33], s[3 * 33]); o.z = pk2(s[4 * 33], s[5 * 33]); o.w = pk2(s[6 * 33], s[7 * 33]);
        if (n < N) *(GAS v4u*)(WT + (size_t)dst_row<MODE>(n) * K + k0 + 8 * c) = o; }
    LDS_WAIT(); asm volatile("" ::: "memory");
}
__device__ __forceinline__ void p0_prologue(const Args& a, LAS unsigned char* lds, int tid, int lane, int wave, int bid, int G) {
    {
        LAS float* sc = (LAS float*)lds;
        LAS float* red = (LAS float*)(lds + 40960);
        float* mods = (float*)(a.ws + WS_MODS);
        for (int i = tid; i < 5 * D; i += NWAVES * 64) { const int r = i >> 11, k = i & 2047; const float v = r < 4 ? a.in[I_C][r * D + k] : a.in[I_CCTX][k]; sc[i] = siluf(v); }
        __syncthreads();
        for (int unit = bid; unit < 192; unit += G) {
            const int l = unit / 96, n0 = (unit % 96) * 128;
            const float* W = a.in[I_ADAW] + (size_t)l * D * (6 * D) + n0 + 2 * lane;
            float acc[5][2];
#pragma unroll
            for (int r = 0; r < 5; ++r) { acc[r][0] = 0.f; acc[r][1] = 0.f; }
            const int kbeg = wave * 256;
#pragma unroll 16
            for (int kk = 0; kk < 256; ++kk) { const int k = kbeg + kk; const f32x2 w = *(const f32x2*)(W + (size_t)k * (6 * D));
#pragma unroll
                for (int r = 0; r < 5; ++r) { const float s = sc[r * D + k]; acc[r][0] += s * w.x; acc[r][1] += s * w.y; } }
#pragma unroll
            for (int r = 0; r < 5; ++r) { red[(wave * 5 + r) * 128 + 2 * lane] = acc[r][0]; red[(wave * 5 + r) * 128 + 2 * lane + 1] = acc[r][1]; }
            __syncthreads();
            for (int o = tid; o < 640; o += NWAVES * 64) { const int r = o >> 7, c = o & 127; float s = 0.f;
#pragma unroll
                for (int w = 0; w < 8; ++w) s += red[(w * 5 + r) * 128 + c];
                mods[(size_t)(l * 5 + r) * (6 * D) + n0 + c] = s + a.in[I_ADAB][l * 6 * D + n0 + c]; }
            __syncthreads();
        }
    }
    if (bid >= 192) { for (int u = bid - 192; u < 128; u += G - 192) s5_tables_unit(a, lds, tid, u); }
    {
        LAS float* scr = (LAS float*)(lds + 61440 + wave * 8448);
        const int gw = bid * NWAVES + wave, NGW = G * NWAVES;
        constexpr int IT_IN = 32 * 186, IT_OUT = 32 * 64, IT_G = 32 * 176, IT_D = 88 * 64, IT_GLU = 8 * 16, IT_LAYER = IT_IN + IT_OUT + 2 * IT_G + IT_D + IT_GLU;
        for (int it = gw; it < DEPTH * IT_LAYER; it += NGW) {
            const int l = it / IT_LAYER; int r = it % IT_LAYER; unsigned char* wl = a.ws + WS_W + (size_t)l * W_LAYER;
            if (r < IT_IN) { transpose_item<1>(a.in[I_WIN] + (size_t)l * D * NPROJ, D, NPROJ, (bf16*)wl, scr, r, lane); continue; } r -= IT_IN;
            if (r < IT_OUT) { transpose_item<0>(a.in[I_WOUT] + (size_t)l * D * D, D, D, (bf16*)(wl + WO_OFF), scr, r, lane); continue; } r -= IT_OUT;
            if (r < IT_G) { transpose_item<2>(a.in[I_WG] + (size_t)l * D * FF, D, FF, (bf16*)(wl + WGU_OFF), scr, r, lane); continue; } r -= IT_G;
            if (r < IT_G) { transpose_item<3>(a.in[I_WU] + (size_t)l * D * FF, D, FF, (bf16*)(wl + WGU_OFF), scr, r, lane); continue; } r -= IT_G;
            if (r < IT_D) { transpose_item<0>(a.in[I_WD] + (size_t)l * FF * D, FF, D, (bf16*)(wl + WD_OFF), scr, r, lane); continue; } r -= IT_D;
            transpose_item<0>(a.in[I_GLUW] + (size_t)l * 512 * 512, 512, 512, (bf16*)(wl + WGLU_OFF), scr, r, lane);
        }
        constexpr int ZV = (N1 - NPROJ) * D * 2 / 16;
        for (int i = bid * NWAVES * 64 + tid; i < DEPTH * ZV; i += G * NWAVES * 64) { const int l = i / ZV, r = i % ZV;
            *(GAS v4u*)(a.ws + WS_W + (size_t)l * W_LAYER + (size_t)NPROJ * D * 2 + (size_t)r * 16) = (v4u){0u, 0u, 0u, 0u}; }
    }
}

template <bool SRC_IN, bool HAS_R, bool WRITE_X, bool WRITE_OUT, bool MAKE_A>
__device__ __forceinline__ void rowpass(const Args& a, int gw, int NGW, int lane, int nrows, int l, int gate_chunk, const float* gpost, int la, const float* gpre, int sh_chunk, int sc_chunk) {
    const float* mods = (const float*)(a.ws + WS_MODS);
    float* xbuf = (float*)(a.ws + WS_XBUF);
    const float* R = (const float*)(a.ws + WS_R);
    bf16* A = (bf16*)(a.ws + WS_ABUF);
    for (int row = gw; row < nrows; row += NGW) {
        const int r5 = row < ML ? row / TL : 4;
        const float* xs = SRC_IN ? (row < ML ? a.in[I_X] + (size_t)row * D : a.in[I_CTX] + (size_t)(row - ML) * D) : xbuf + (size_t)row * D;
        f32x4 xv[8];
#pragma unroll
        for (int j = 0; j < 8; ++j) xv[j] = *(const f32x4*)(xs + 4 * lane + 256 * j);
        if (HAS_R) {
            f32x4 rv[8]; float ss = 0.f;
#pragma unroll
            for (int j = 0; j < 8; ++j) { rv[j] = *(const f32x4*)(R + (size_t)row * D + 4 * lane + 256 * j); ss += (rv[j].x * rv[j].x + rv[j].y * rv[j].y) + (rv[j].z * rv[j].z + rv[j].w * rv[j].w); }
            const float rstd = 1.0f / sqrtf(wave_sum(ss) * (1.0f / D) + EPS);
            const float* mg = mods + ((size_t)(l * 5 + r5) * 6 + gate_chunk) * D;
#pragma unroll
            for (int j = 0; j < 8; ++j) { const int c = 4 * lane + 256 * j; const f32x4 g = *(const f32x4*)(gpost + c), gt = *(const f32x4*)(mg + c);
                xv[j] = xv[j] + gt * (rv[j] * rstd * g);
                if (WRITE_X) *(f32x4*)(xbuf + (size_t)row * D + c) = xv[j];
                if (WRITE_OUT) *(f32x4*)(a.out + (size_t)row * D + c) = xv[j]; }
        }
        if (MAKE_A) {
            float ss = 0.f;
#pragma unroll
            for (int j = 0; j < 8; ++j) ss += (xv[j].x * xv[j].x + xv[j].y * xv[j].y) + (xv[j].z * xv[j].z + xv[j].w * xv[j].w);
            const float rstd = 1.0f / sqrtf(wave_sum(ss) * (1.0f / D) + EPS);
            const float* msh = mods + ((size_t)(la * 5 + r5) * 6 + sh_chunk) * D; const float* msc = mods + ((size_t)(la * 5 + r5) * 6 + sc_chunk) * D;
#pragma unroll
            for (int j = 0; j < 8; ++j) { const int c = 4 * lane + 256 * j; const f32x4 g = *(const f32x4*)(gpre + c), sh = *(const f32x4*)(msh + c), sc = *(const f32x4*)(msc + c);
                const f32x4 v = xv[j] * rstd * g * (sc + 1.0f) + sh;
                v2u o; o.x = pk2(v.x, v.y); o.y = pk2(v.z, v.w);
                *(v2u*)(A + (size_t)row * D + c) = o; }
        }
    }
}

__device__ __forceinline__ void s5_unit(const Args& a, LAS unsigned char* lds, int tid_in, int l, int unit) {
    int tid = tid_in; asm volatile("" : "+v"(tid));
    const int lane = tid & 63, wave = __builtin_amdgcn_readfirstlane(tid >> 6);
    const int b = unit >> 6, g = (unit >> 1) & 31, d = unit & 1, p = lane;
    const int dg = (l * 2 + d) * 32 + g;
    const float lre = a.in[I_LAMRE][dg * 64 + p], lim = a.in[I_LAMIM][dg * 64 + p], dt = expf(a.in[I_LOGDT][dg]);
    const float mag = expf(lre * dt), ang = lim * dt;
    const float abr = mag * cosf(ang), abi = mag * sinf(ang);
    const float den = lre * lre + lim * lim;
    const float f_re = ((abr - 1.f) * lre + abi * lim) / den, f_im = (abi * lre - (abr - 1.f) * lim) / den;
    float bbr[16], bbi[16], cr[16], ci[16];
#pragma unroll
    for (int h = 0; h < 16; ++h) { const float br = a.in[I_BRE][(size_t)(dg * 64 + p) * 16 + h], bi = a.in[I_BIM][(size_t)(dg * 64 + p) * 16 + h];
        bbr[h] = f_re * br - f_im * bi; bbi[h] = f_re * bi + f_im * br;
        cr[h] = a.in[I_CRE][(size_t)(dg * 16 + h) * 64 + p]; ci[h] = a.in[I_CIM][(size_t)(dg * 16 + h) * 64 + p]; }
    float a64r = abr, a64i = abi;
#pragma unroll
    for (int q = 0; q < 6; ++q) { const float t = a64r * a64r - a64i * a64i; a64i = 2.f * a64r * a64i; a64r = t; }
    LAS float* ub = (LAS float*)(lds + wave * 4096);
    LAS float* E = (LAS float*)(lds + 32768);
    LAS float* SI = (LAS float*)(lds + 32768 + 18432);
    const bf16* P = (const bf16*)(a.ws + WS_PBUF);
    float* Y = (float*)(a.ws + WS_YS5) + (size_t)d * MA * 512;
#define S5_LOAD_U(c) do { const int row_ = scan_row(b, (c), lane, d); const v4u* up_ = (const v4u*)(P + (size_t)row_ * LDP + PC_U + g * 16); const v4u u0_ = up_[0], u1_ = up_[1]; \
        LAS f32x4* ud_ = (LAS f32x4*)(ub + lane * 16); \
        ud_[0] = (f32x4){bflo(u0_.x), bfhi(u0_.x), bflo(u0_.y), bfhi(u0_.y)}; ud_[1] = (f32x4){bflo(u0_.z), bfhi(u0_.z), bflo(u0_.w), bfhi(u0_.w)}; \
        ud_[2] = (f32x4){bflo(u1_.x), bfhi(u1_.x), bflo(u1_.y), bfhi(u1_.y)}; ud_[3] = (f32x4){bflo(u1_.z), bfhi(u1_.z), bflo(u1_.w), bfhi(u1_.w)}; \
        LDS_WAIT(); asm volatile("" ::: "memory"); } while (0)
#define S5_STEP(i) do { const LAS f32x4* us_ = (const LAS f32x4*)(ub + (i) * 16); const f32x4 q0 = us_[0], q1 = us_[1], q2 = us_[2], q3 = us_[3]; \
        const float uu[16] = {q0.x, q0.y, q0.z, q0.w, q1.x, q1.y, q1.z, q1.w, q2.x, q2.y, q2.z, q2.w, q3.x, q3.y, q3.z, q3.w}; \
        float bur = 0.f, bui = 0.f; \
        _Pragma("unroll") for (int h = 0; h < 16; ++h) { bur += bbr[h] * uu[h]; bui += bbi[h] * uu[h]; } \
        const float nr_ = abr * sr - abi * si + bur, ni_ = abr * si + abi * sr + bui; sr = nr_; si = ni_; } while (0)
    for (int c = wave; c < 36; c += 8) {
        S5_LOAD_U(c);
        float sr = 0.f, si = 0.f;
        for (int i = 0; i < 64; ++i) S5_STEP(i);
        E[(c * 64 + p) * 2] = sr; E[(c * 64 + p) * 2 + 1] = si;
        asm volatile("" ::: "memory");
    }
    __syncthreads();
    if (wave == 0) { float cr_ = 0.f, ci_ = 0.f;
        for (int c = 0; c < 36; ++c) { SI[(c * 64 + p) * 2] = cr_; SI[(c * 64 + p) * 2 + 1] = ci_; const float er = E[(c * 64 + p) * 2], ei = E[(c * 64 + p) * 2 + 1];
            const float nr_ = a64r * cr_ - a64i * ci_ + er, ni_ = a64r * ci_ + a64i * cr_ + ei; cr_ = nr_; ci_ = ni_; } }
    __syncthreads();
    for (int c = wave; c < 36; c += 8) {
        S5_LOAD_U(c);
        float sr = SI[(c * 64 + p) * 2], si = SI[(c * 64 + p) * 2 + 1];
        for (int i = 0; i < 64; ++i) {
            S5_STEP(i);
            float v[16];
#pragma unroll
            for (int h = 0; h < 16; ++h) v[h] = cr[h] * sr - ci[h] * si;
            float w8[8], w4[4], w2[2];
            { const bool up = (lane & 32) != 0;
#pragma unroll
              for (int k = 0; k < 8; ++k) { const float send = up ? v[k] : v[k + 8], keep = up ? v[k + 8] : v[k]; w8[k] = keep + __shfl_xor(send, 32); } }
            { const bool up = (lane & 16) != 0;
#pragma unroll
              for (int k = 0; k < 4; ++k) { const float send = up ? w8[k] : w8[k + 4], keep = up ? w8[k + 4] : w8[k]; w4[k] = keep + __shfl_xor(send, 16); } }
            { const bool up = (lane & 8) != 0;
#pragma unroll
              for (int k = 0; k < 2; ++k) { const float send = up ? w4[k] : w4[k + 2], keep = up ? w4[k + 2] : w4[k]; w2[k] = keep + __shfl_xor(send, 8); } }
            float y;
            { const bool up = (lane & 4) != 0; const float send = up ? w2[0] : w2[1], keep = up ? w2[1] : w2[0]; y = keep + __shfl_xor(send, 4); }
            y += __shfl_xor(y, 1); y += __shfl_xor(y, 2);
            const int row = scan_row(b, c, i, d);
            if ((lane & 3) == 0) Y[(size_t)row * 512 + g * 16 + (lane >> 2)] = y;
        }
    }
    __syncthreads();
#undef S5_LOAD_U
#undef S5_STEP
}

__device__ __forceinline__ void gdn_chain(const Args& a, LAS unsigned char* lds, int tid, int l, int chain) {
    const int b = chain / 12, h = (chain >> 1) % 6, d = chain & 1;
    LAS float* qs = (LAS float*)lds; LAS float* ks = qs + 2048; LAS float* vs = ks + 2048; LAS float* egs = vs + 2048; LAS float* bes = egs + 16; LAS int* rws = (LAS int*)(bes + 16);
    const bf16* P = (const bf16*)(a.ws + WS_PBUF); const float* Gt = (const float*)(a.ws + WS_GBUF);
    float* O = (float*)(a.ws + WS_OG) + (size_t)d * MA * 768;
    const int sii = tid >> 5, l32 = tid & 31, c4 = 4 * l32;
    float wq[3][4], wk[3][4], wv[3][4];
    { const float* cw = a.in[I_CONVW] + (size_t)l * 3 * 2304;
#pragma unroll
      for (int j = 0; j < 3; ++j)
#pragma unroll
          for (int e = 0; e < 4; ++e) { wq[j][e] = cw[j * 2304 + h * 128 + c4 + e]; wk[j][e] = cw[j * 2304 + 768 + h * 128 + c4 + e]; wv[j][e] = cw[j * 2304 + 1536 + h * 128 + c4 + e]; } }
    const float nalog = -expf(a.in[I_ALOG][(l * 2 + d) * 6 + h]), dtb = a.in[I_DTB][(l * 2 + d) * 6 + h];
    const int j = tid >> 2, r = tid & 3;
    float S[32];
#pragma unroll
    for (int i = 0; i < 32; ++i) S[i] = 0.f;
    for (int blk = 0; blk < 144; ++blk) {
        const bool isc = blk < 16; const int T = isc ? TC : TL, pos0 = (isc ? blk : blk - 16) * 16;
        {
            const int pos = pos0 + sii, t = d ? T - 1 - pos : pos, row = isc ? ML + b * TC + t : b * TL + t;
            const bf16* pr = P + (size_t)row * LDP + h * 128 + c4;
            const bool hm = t > 0, hp = t < T - 1;
            float yq[4], yk[4], yv[4];
#define GDN_CONV(dst, base, w) do { const v2u x0 = *(const v2u*)(pr + (base)); v2u xm = (v2u){0u, 0u}, xp = (v2u){0u, 0u}; if (hm) xm = *(const v2u*)(pr + (base) - LDP); if (hp) xp = *(const v2u*)(pr + (base) + LDP); \
            dst[0] = siluf(w[0][0] * bflo(xm.x) + w[1][0] * bflo(x0.x) + w[2][0] * bflo(xp.x)); dst[1] = siluf(w[0][1] * bfhi(xm.x) + w[1][1] * bfhi(x0.x) + w[2][1] * bfhi(xp.x)); \
            dst[2] = siluf(w[0][2] * bflo(xm.y) + w[1][2] * bflo(x0.y) + w[2][2] * bflo(xp.y)); dst[3] = siluf(w[0][3] * bfhi(xm.y) + w[1][3] * bfhi(x0.y) + w[2][3] * bfhi(xp.y)); } while (0)
            GDN_CONV(yq, PC_GQ, wq); GDN_CONV(yk, PC_GK, wk); GDN_CONV(yv, PC_GV, wv);
#undef GDN_CONV
            float sq = yq[0] * yq[0] + yq[1] * yq[1] + yq[2] * yq[2] + yq[3] * yq[3], sk = yk[0] * yk[0] + yk[1] * yk[1] + yk[2] * yk[2] + yk[3] * yk[3];
#pragma unroll
            for (int o = 1; o < 32; o <<= 1) { sq += __shfl_xor(sq, o); sk += __shfl_xor(sk, o); }
            const float rq = (1.0f / sqrtf(sq + EPS)) * 0.08838834764831845f, rk = 1.0f / sqrtf(sk + EPS);
            *(LAS f32x4*)(qs + sii * 128 + c4) = (f32x4){yq[0] * rq, yq[1] * rq, yq[2] * rq, yq[3] * rq};
            *(LAS f32x4*)(ks + sii * 128 + c4) = (f32x4){yk[0] * rk, yk[1] * rk, yk[2] * rk, yk[3] * rk};
            *(LAS f32x4*)(vs + sii * 128 + c4) = (f32x4){yv[0], yv[1], yv[2], yv[3]};
            if (l32 == 0) { const float av = Gt[(size_t)row * 128 + GC_A + d * 6 + h], bv = Gt[(size_t)row * 128 + GC_B + d * 6 + h];
                egs[sii] = expf(nalog * softplusf(av + dtb)); bes[sii] = sigm(bv); rws[sii] = row; }
        }
        __syncthreads();
        for (int ii = 0; ii < 16; ++ii) {
            const float eg = egs[ii], be = bes[ii]; const int row = rws[ii];
            float kk[32];
#pragma unroll
            for (int i = 0; i < 8; ++i) { const f32x4 t4 = *(const LAS f32x4*)(ks + ii * 128 + 32 * r + 4 * i); kk[4 * i] = t4.x; kk[4 * i + 1] = t4.y; kk[4 * i + 2] = t4.z; kk[4 * i + 3] = t4.w; }
            float p0 = 0.f, p1 = 0.f, p2 = 0.f, p3 = 0.f;
#pragma unroll
            for (int i = 0; i < 8; ++i) { p0 += S[4 * i] * kk[4 * i]; p1 += S[4 * i + 1] * kk[4 * i + 1]; p2 += S[4 * i + 2] * kk[4 * i + 2]; p3 += S[4 * i + 3] * kk[4 * i + 3]; }
            float kS = (p0 + p1) + (p2 + p3); kS += __shfl_xor(kS, 1); kS += __shfl_xor(kS, 2);
            const float vn = be * (vs[ii * 128 + j] - eg * kS);
            float o0 = 0.f, o1 = 0.f, o2 = 0.f, o3 = 0.f;
#pragma unroll
            for (int i = 0; i < 8; ++i) { const f32x4 q4 = *(const LAS f32x4*)(qs + ii * 128 + 32 * r + 4 * i);
                S[4 * i] = eg * S[4 * i] + kk[4 * i] * vn; S[4 * i + 1] = eg * S[4 * i + 1] + kk[4 * i + 1] * vn; S[4 * i + 2] = eg * S[4 * i + 2] + kk[4 * i + 2] * vn; S[4 * i + 3] = eg * S[4 * i + 3] + kk[4 * i + 3] * vn;
                o0 += S[4 * i] * q4.x; o1 += S[4 * i + 1] * q4.y; o2 += S[4 * i + 2] * q4.z; o3 += S[4 * i + 3] * q4.w; }
            float ov = (o0 + o1) + (o2 + o3); ov += __shfl_xor(ov, 1); ov += __shfl_xor(ov, 2);
            if (r == 0) O[(size_t)row * 768 + h * 128 + j] = ov;
        }
        __syncthreads();
    }
}

__device__ __forceinline__ void mlstm_chain(const Args& a, LAS unsigned char* lds, int tid, int l, int chain) {
    const int b = chain / 12, h = (chain >> 1) % 6, d = chain & 1;
    LAS float* qs = (LAS float*)lds; LAS float* ks = qs + 1024; LAS float* vs = ks + 1024; LAS float* igs = vs + 2048; LAS float* lfs = igs + 16; LAS int* rws = (LAS int*)(lfs + 16);
    const bf16* P = (const bf16*)(a.ws + WS_PBUF); const float* Gt = (const float*)(a.ws + WS_GBUF);
    float* H = (float*)(a.ws + WS_HM) + (size_t)d * MA * 768;
    const int sii = tid >> 5, l32 = tid & 31;
    const float ib = a.in[I_IB][(l * 2 + d) * 6 + h], fb = a.in[I_FB][(l * 2 + d) * 6 + h];
    const int j = tid >> 2, r = tid & 3;
    float Cs[16], ns[16], m = 0.f;
#pragma unroll
    for (int i = 0; i < 16; ++i) { Cs[i] = 0.f; ns[i] = 0.f; }
    for (int blk = 0; blk < 144; ++blk) {
        const bool isc = blk < 16; const int pos0 = (isc ? blk : blk - 16) * 16;
        {
            const int pos = pos0 + sii; int row;
            if (isc) { const int t = d ? TC - 1 - pos : pos; row = ML + b * TC + t; }
            else { const int p = d ? TL - 1 - pos : pos; const int t = (p & 31) * 64 + (p >> 5); row = b * TL + t; }
            const bf16* pr = P + (size_t)row * LDP;
            const unsigned q2 = *(const unsigned*)(pr + PC_MQ + h * 64 + 2 * l32), k2 = *(const unsigned*)(pr + PC_MK + h * 64 + 2 * l32);
            const v2u v4 = *(const v2u*)(pr + PC_MV + h * 128 + 4 * l32);
            *(LAS f32x2*)(qs + sii * 64 + 2 * l32) = (f32x2){bflo(q2) * 0.125f, bfhi(q2) * 0.125f};
            *(LAS f32x2*)(ks + sii * 64 + 2 * l32) = (f32x2){bflo(k2), bfhi(k2)};
            *(LAS f32x4*)(vs + sii * 128 + 4 * l32) = (f32x4){bflo(v4.x), bfhi(v4.x), bflo(v4.y), bfhi(v4.y)};
            if (l32 == 0) { igs[sii] = Gt[(size_t)row * 128 + GC_I + d * 6 + h] + ib; lfs[sii] = logsigmoidf(Gt[(size_t)row * 128 + GC_F + d * 6 + h] + fb); rws[sii] = row; }
        }
        __syncthreads();
        for (int ii = 0; ii < 16; ++ii) {
            const float ig = igs[ii], lf = lfs[ii]; const int row = rws[ii];
            const float mn = fmaxf(lf + m, ig), fp = expf(lf + m - mn), ip = expf(ig - mn); m = mn;
            const float vj = vs[ii * 128 + j] * ip;
            float num = 0.f, den = 0.f;
#pragma unroll
            for (int i = 0; i < 4; ++i) { const f32x4 k4 = *(const LAS f32x4*)(ks + ii * 64 + 16 * r + 4 * i), q4 = *(const LAS f32x4*)(qs + ii * 64 + 16 * r + 4 * i);
                Cs[4 * i] = fp * Cs[4 * i] + k4.x * vj; Cs[4 * i + 1] = fp * Cs[4 * i + 1] + k4.y * vj; Cs[4 * i + 2] = fp * Cs[4 * i + 2] + k4.z * vj; Cs[4 * i + 3] = fp * Cs[4 * i + 3] + k4.w * vj;
                ns[4 * i] = fp * ns[4 * i] + ip * k4.x; ns[4 * i + 1] = fp * ns[4 * i + 1] + ip * k4.y; ns[4 * i + 2] = fp * ns[4 * i + 2] + ip * k4.z; ns[4 * i + 3] = fp * ns[4 * i + 3] + ip * k4.w;
                num += (Cs[4 * i] * q4.x + Cs[4 * i + 1] * q4.y) + (Cs[4 * i + 2] * q4.z + Cs[4 * i + 3] * q4.w);
                den += (ns[4 * i] * q4.x + ns[4 * i + 1] * q4.y) + (ns[4 * i + 2] * q4.z + ns[4 * i + 3] * q4.w); }
            num += __shfl_xor(num, 1); num += __shfl_xor(num, 2); den += __shfl_xor(den, 1); den += __shfl_xor(den, 2);
            const float hv = num / fmaxf(fabsf(den), expf(-m));
            if (r == 0) H[(size_t)row * 768 + h * 128 + j] = hv;
        }
        __syncthreads();
    }
}

__device__ __forceinline__ void finalize_rows(const Args& a, int gw, int NGW, int lane, int nrows, int l) {
    const bf16* P = (const bf16*)(a.ws + WS_PBUF);
    const float* Y0 = (const float*)(a.ws + WS_YS5); const float* Y1 = Y0 + (size_t)MA * 512;
    const float* O0 = (const float*)(a.ws + WS_OG); const float* O1 = O0 + (size_t)MA * 768;
    const float* H0 = (const float*)(a.ws + WS_HM); const float* H1 = H0 + (size_t)MA * 768;
    bf16* MIX = (bf16*)(a.ws + WS_MIX); bf16* Y5 = (bf16*)(a.ws + WS_Y5);
    const float* s5d = a.in[I_S5D] + l * 512; const float* gnorm = a.in[I_GNORM] + l * 128; const float* mnorm = a.in[I_MNORM] + l * 128;
    for (int row = gw; row < nrows; row += NGW) {
        {
            const int c0 = 8 * lane;
            const f32x4 a0 = *(const f32x4*)(Y0 + (size_t)row * 512 + c0), a1 = *(const f32x4*)(Y0 + (size_t)row * 512 + c0 + 4);
            const f32x4 b0 = *(const f32x4*)(Y1 + (size_t)row * 512 + c0), b1 = *(const f32x4*)(Y1 + (size_t)row * 512 + c0 + 4);
            const f32x4 d0 = *(const f32x4*)(s5d + c0), d1 = *(const f32x4*)(s5d + c0 + 4);
            const v4u uu = *(const v4u*)(P + (size_t)row * LDP + PC_U + c0);
            const f32x4 u0 = (f32x4){bflo(uu.x), bfhi(uu.x), bflo(uu.y), bfhi(uu.y)}, u1 = (f32x4){bflo(uu.z), bfhi(uu.z), bflo(uu.w), bfhi(uu.w)};
            const f32x4 y0 = a0 + b0 + d0 * u0, y1 = a1 + b1 + d1 * u1;
            v4u o; o.x = pk2(gelu_tanh(y0.x), gelu_tanh(y0.y)); o.y = pk2(gelu_tanh(y0.z), gelu_tanh(y0.w)); o.z = pk2(gelu_tanh(y1.x), gelu_tanh(y1.y)); o.w = pk2(gelu_tanh(y1.z), gelu_tanh(y1.w));
            *(v4u*)(Y5 + (size_t)row * 512 + c0) = o;
        }
#pragma unroll 1
        for (int hh = 0; hh < 6; ++hh) {
            const int c = hh * 128 + 2 * lane;
            const f32x2 of = *(const f32x2*)(O0 + (size_t)row * 768 + c), ob = *(const f32x2*)(O1 + (size_t)row * 768 + c);
            const float ox = of.x + ob.x, oy = of.y + ob.y;
            const float sc = 1.0f / sqrtf(wave_sum(ox * ox + oy * oy) * (1.0f / 128.f) + EPS);
            const f32x2 gn = *(const f32x2*)(gnorm + 2 * lane);
            const unsigned z2 = *(const unsigned*)(P + (size_t)row * LDP + PC_GZ + c);
            *(unsigned*)(MIX + (size_t)row * D + 512 + c) = pk2(ox * sc * gn.x * siluf(bflo(z2)), oy * sc * gn.y * siluf(bfhi(z2)));
        }
#pragma unroll 1
        for (int hh = 0; hh < 6; ++hh) {
            const int c = hh * 128 + 2 * lane;
            const f32x2 hf = *(const f32x2*)(H0 + (size_t)row * 768 + c), hb = *(const f32x2*)(H1 + (size_t)row * 768 + c);
            const float hx = hf.x + hb.x, hy = hf.y + hb.y;
            const float sc = 1.0f / sqrtf(wave_sum(hx * hx + hy * hy) * (1.0f / 128.f) + EPS);
            const f32x2 gn = *(const f32x2*)(mnorm + 2 * lane);
            const unsigned o2 = *(const unsigned*)(P + (size_t)row * LDP + PC_MO + c);
            *(unsigned*)(MIX + (size_t)row * D + 1280 + c) = pk2(hx * sc * gn.x * sigm(bflo(o2)), hy * sc * gn.y * sigm(bfhi(o2)));
        }
    }
}

typedef short bf16x8 __attribute__((ext_vector_type(8)));
__device__ __forceinline__ f32x4 mfma16(bf16x8 a, bf16x8 b, f32x4 c) { return __builtin_amdgcn_mfma_f32_16x16x32_bf16(a, b, c, 0, 0, 0); }
__device__ __forceinline__ bf16x8 ldsfrag(const LAS unsigned char* p) { return *(const LAS bf16x8*)p; }
__device__ __forceinline__ bf16x8 glbfrag(const unsigned char* p) { return *(const bf16x8*)p; }
__device__ __forceinline__ float bf2f(unsigned short v) { return __uint_as_float((unsigned)v << 16); }

constexpr size_t GB_W = 0, GB_QD = 16384, GB_KDT = 32768, GB_QKD = 49152, GB_UT = 57344, GB_GT = 90112, GB_BYTES = 90368;
__device__ __forceinline__ void gdn_prep_unit(const Args& a, LAS unsigned char* lds, int tid_in, int l, int unit) {
    int tid = tid_in; asm volatile("" : "+v"(tid));
    const int lane = tid & 63, wave = __builtin_amdgcn_readfirstlane(tid >> 6);
    const int h = unit % 6, c = (unit / 6) % 36, b = unit / 216;
    LAS unsigned char* Qh = lds;
    LAS unsigned char* Kh = lds + 17408;
    LAS float* Vf = (LAS float*)(lds + 34816);
    LAS float* Mm = (LAS float*)(lds + 67584);
    LAS float* gcs = (LAS float*)(lds + 100352);
    LAS float* Kf = (LAS float*)(lds + 101376);
    LAS float* bes = gcs + 128;
    LAS float* scl = (LAS float*)(lds + 134144);
    const bf16* P = (const bf16*)(a.ws + WS_PBUF); const float* Gt = (const float*)(a.ws + WS_GBUF);
    const bool isc = c < 4; const int T = isc ? TC : TL, t0 = (isc ? c : c - 4) * 64, row0 = isc ? ML + b * TC + t0 : b * TL + t0;
    unsigned char* const blk0 = a.ws + WS_GDN + ((size_t)((b * 6 + h) * 2 + 0) * 36 + c) * GB_BYTES;
    unsigned char* const blk1 = a.ws + WS_GDN + ((size_t)((b * 6 + h) * 2 + 1) * 36 + (isc ? 3 - c : 39 - c)) * GB_BYTES;
#define BLK(d) ((d) ? blk1 : blk0)
    const int q = lane >> 4, r16 = lane & 15;
    {
        const int l32 = tid & 31, tg = tid >> 5, c4 = 4 * l32;
        float wq[3][4], wk[3][4], wv[3][4];
        { const float* cw = a.in[I_CONVW] + (size_t)l * 3 * 2304;
#pragma unroll
          for (int j = 0; j < 3; ++j)
#pragma unroll
              for (int e = 0; e < 4; ++e) { wq[j][e] = cw[j * 2304 + h * 128 + c4 + e]; wk[j][e] = cw[j * 2304 + 768 + h * 128 + c4 + e]; wv[j][e] = cw[j * 2304 + 1536 + h * 128 + c4 + e]; } }
#pragma unroll
        for (int rr = 0; rr < 4; ++rr) {
            const int n = tg + 16 * rr, t = t0 + n;
            const bf16* pr = P + (size_t)(row0 + n) * LDP + h * 128 + c4;
            const bool hm = t > 0, hp = t < T - 1;
            float yq[4], yk[4], yv[4];
#define GDN_CONV(dst, base, w) do { const v2u x0 = *(const v2u*)(pr + (base)); v2u xm = (v2u){0u, 0u}, xp = (v2u){0u, 0u}; if (hm) xm = *(const v2u*)(pr + (base) - LDP); if (hp) xp = *(const v2u*)(pr + (base) + LDP); \
            dst[0] = siluf(w[0][0] * bflo(xm.x) + w[1][0] * bflo(x0.x) + w[2][0] * bflo(xp.x)); dst[1] = siluf(w[0][1] * bfhi(xm.x) + w[1][1] * bfhi(x0.x) + w[2][1] * bfhi(xp.x)); \
            dst[2] = siluf(w[0][2] * bflo(xm.y) + w[1][2] * bflo(x0.y) + w[2][2] * bflo(xp.y)); dst[3] = siluf(w[0][3] * bfhi(xm.y) + w[1][3] * bfhi(x0.y) + w[2][3] * bfhi(xp.y)); } while (0)
            GDN_CONV(yq, PC_GQ, wq); GDN_CONV(yk, PC_GK, wk); GDN_CONV(yv, PC_GV, wv);
#undef GDN_CONV
            float sq = yq[0] * yq[0] + yq[1] * yq[1] + yq[2] * yq[2] + yq[3] * yq[3], sk = yk[0] * yk[0] + yk[1] * yk[1] + yk[2] * yk[2] + yk[3] * yk[3];
#pragma unroll
            for (int o = 1; o < 32; o <<= 1) { sq += __shfl_xor(sq, o); sk += __shfl_xor(sk, o); }
            const float rq = (1.0f / sqrtf(sq + EPS)) * 0.08838834764831845f, rk = 1.0f / sqrtf(sk + EPS);
            *(LAS v2u*)(Qh + n * 272 + c4 * 2) = (v2u){pk2(yq[0] * rq, yq[1] * rq), pk2(yq[2] * rq, yq[3] * rq)};
            *(LAS v2u*)(Kh + n * 272 + c4 * 2) = (v2u){pk2(yk[0] * rk, yk[1] * rk), pk2(yk[2] * rk, yk[3] * rk)};
            *(LAS f32x4*)(Vf + n * 128 + c4) = (f32x4){yv[0], yv[1], yv[2], yv[3]};
            *(LAS f32x4*)(Kf + n * 128 + c4) = (f32x4){yk[0] * rk, yk[1] * rk, yk[2] * rk, yk[3] * rk};
        }
    }
    if (wave < 2) {
        const int d = wave, n = d ? 63 - lane : lane;
        const float av = Gt[(size_t)(row0 + n) * 128 + GC_A + d * 6 + h], bv = Gt[(size_t)(row0 + n) * 128 + GC_B + d * 6 + h];
        float g = -expf(a.in[I_ALOG][(l * 2 + d) * 6 + h]) * softplusf(av + a.in[I_DTB][(l * 2 + d) * 6 + h]);
#pragma unroll
        for (int o = 1; o < 64; o <<= 1) { const float t_ = __shfl_up(g, o); if (lane >= o) g += t_; }
        const float bsg = sigm(bv);
        gcs[d * 64 + lane] = g; bes[d * 64 + lane] = bsg; scl[d * 128 + lane] = bsg; scl[d * 128 + 64 + lane] = bsg * __expf(g);
    }
    __syncthreads();
    {
        const int mt = wave & 3; const bool isq = wave >= 4;
        const LAS unsigned char* Ab = (isq ? Qh : Kh) + (16 * mt + r16) * 272 + 16 * q;
        bf16x8 af[4];
#pragma unroll
        for (int ks = 0; ks < 4; ++ks) af[ks] = ldsfrag(Ab + 64 * ks);
#pragma unroll
        for (int nt = 0; nt < 4; ++nt) {
            f32x4 acc = (f32x4){0.f, 0.f, 0.f, 0.f};
#pragma unroll
            for (int ks = 0; ks < 4; ++ks) acc = mfma16(af[ks], ldsfrag(Kh + (16 * nt + r16) * 272 + 16 * q + 64 * ks), acc);
            const int n2 = 16 * nt + r16;
#pragma unroll
            for (int d = 0; d < 2; ++d) {
                const int j = d ? 63 - n2 : n2; const float gj = gcs[d * 64 + j];
#pragma unroll
                for (int rg = 0; rg < 4; ++rg) { const int n1 = 16 * mt + 4 * q + rg, i = d ? 63 - n1 : n1; const float gi = gcs[d * 64 + i];
                    if (!isq) { Mm[(d * 64 + i) * 64 + j] = j < i ? bes[d * 64 + i] * acc[rg] * __expf(gi - gj) : 0.f; }
                    else { *(unsigned short*)(BLK(d) + GB_QKD + (size_t)(i * 64 + j) * 2) = (unsigned short)f2bf(j <= i ? acc[rg] * __expf(gi - gj) : 0.f); } }
            }
        }
    }
    __syncthreads();
    {
        const int d = wave >> 2, cg = wave & 3, col = 64 * (cg & 1) + lane; const bool isk = cg >= 2;
        const LAS float* Md = Mm + d * 4096;
        const LAS float* src = isk ? Kf : Vf;
        const int idx0 = d ? 63 * 128 + col : col, istep = d ? -128 : 128, sc0 = d * 128 + (isk ? 64 : 0);
        float x[64];
#pragma unroll
        for (int i = 0; i < 64; ++i) {
            int o = idx0 + i * istep, o2 = sc0;
            if (i > 0) asm volatile("" : "+v"(o), "+v"(o2) : "v"(x[i - 1]));
            float acc = scl[o2 + i] * src[o], s0 = 0.f, s1 = 0.f, s2 = 0.f, s3 = 0.f;
#pragma unroll
            for (int j4 = 0; j4 < (i + 3) / 4; ++j4) { const f32x4 m4 = *(const LAS f32x4*)(Md + i * 64 + 4 * j4);
                if (4 * j4 + 0 < i) s0 += m4.x * x[4 * j4 + 0];
                if (4 * j4 + 1 < i) s1 += m4.y * x[4 * j4 + 1];
                if (4 * j4 + 2 < i) s2 += m4.z * x[4 * j4 + 2];
                if (4 * j4 + 3 < i) s3 += m4.w * x[4 * j4 + 3]; }
            acc -= (s0 + s1) + (s2 + s3);
            x[i] = acc;
        }
        if (!isk) { float* up = (float*)(BLK(d) + GB_UT) + (size_t)col * 64;
#pragma unroll
            for (int i4 = 0; i4 < 16; ++i4) *(f32x4*)(up + 4 * i4) = (f32x4){x[4 * i4], x[4 * i4 + 1], x[4 * i4 + 2], x[4 * i4 + 3]}; }
        else { unsigned short* wp = (unsigned short*)(BLK(d) + GB_W) + col;
#pragma unroll
            for (int i = 0; i < 64; ++i) wp[i * 128] = (unsigned short)f2bf(x[i]); }
    }
    {
#pragma unroll 1
        for (int it = tid; it < 2048; it += NWAVES * 64) { const int d = it >> 10, i = (it >> 4) & 63, ch = it & 15, n = d ? 63 - i : i; const float sc = __expf(gcs[d * 64 + i]);
            const v4u w = *(const LAS v4u*)(Qh + n * 272 + ch * 16);
            v4u o; o.x = pk2(bflo(w.x) * sc, bfhi(w.x) * sc); o.y = pk2(bflo(w.y) * sc, bfhi(w.y) * sc); o.z = pk2(bflo(w.z) * sc, bfhi(w.z) * sc); o.w = pk2(bflo(w.w) * sc, bfhi(w.w) * sc);
            *(v4u*)(BLK(d) + GB_QD + (size_t)(i * 128 + ch * 8) * 2) = o; }
#pragma unroll 1
        for (int it = tid; it < 2048; it += NWAVES * 64) { const int d = it >> 10, aa = (it >> 3) & 127, j0 = (it & 7) * 8; const float gl = gcs[d * 64 + 63];
            float v[8];
#pragma unroll
            for (int jj = 0; jj < 8; ++jj) { const int j = j0 + jj, n = d ? 63 - j : j; v[jj] = bf2f(*(const LAS unsigned short*)(Kh + n * 272 + aa * 2)) * __expf(gl - gcs[d * 64 + j]); }
            v4u o; o.x = pk2(v[0], v[1]); o.y = pk2(v[2], v[3]); o.z = pk2(v[4], v[5]); o.w = pk2(v[6], v[7]);
            *(v4u*)(BLK(d) + GB_KDT + (size_t)(aa * 64 + j0) * 2) = o; }
        if (tid < 2) *(float*)(BLK(tid) + GB_GT) = __expf(gcs[tid * 64 + 63]);
    }
    __syncthreads();
#undef BLK
}

struct GdnFrag { bf16x8 fa[4], fkd[2], fqk[2]; f32x4 uu[2]; float gt; };
__device__ __forceinline__ void gdn_loadf(GdnFrag& f, const unsigned char* bp, bool lead, int wave, int wm, int q, int r16, int s) {
#pragma unroll
    for (int ks = 0; ks < 4; ++ks) f.fa[ks] = glbfrag(bp + (lead ? GB_W : GB_QD) + (size_t)((16 * wm + r16) * 128 + 32 * ks + 8 * q) * 2);
#pragma unroll
    for (int ks = 0; ks < 2; ++ks) f.fkd[ks] = glbfrag(bp + GB_KDT + (size_t)((16 * wave + r16) * 64 + 32 * ks + 8 * q) * 2);
#pragma unroll
    for (int ks = 0; ks < 2; ++ks) f.fqk[ks] = glbfrag(bp + GB_QKD + (size_t)((16 * wm + r16) * 64 + 32 * ks + 8 * q) * 2);
#pragma unroll
    for (int nt = 0; nt < 2; ++nt) f.uu[nt] = *(const f32x4*)(bp + GB_UT + (size_t)((32 * s + 16 * nt + r16) * 64 + 16 * wm + 4 * q) * 4);
    f.gt = *(const float*)(bp + GB_GT);
}
__device__ __forceinline__ void gdn_step(const GdnFrag& f, GdnFrag& fn, const unsigned char* gp, int cs, f32x4 (&accS)[2], LAS unsigned char* St, LAS unsigned char* VNt, float* O,
                                         bool lead, int wave, int wm, int q, int r16, int s, int b, int h, int d) {
    f32x4 acc[2] = {(f32x4){0.f, 0.f, 0.f, 0.f}, (f32x4){0.f, 0.f, 0.f, 0.f}};
#pragma unroll
    for (int nt = 0; nt < 2; ++nt)
#pragma unroll
        for (int ks = 0; ks < 4; ++ks) acc[nt] = mfma16(f.fa[ks], ldsfrag(St + (16 * nt + r16) * 272 + 64 * ks + 16 * q), acc[nt]);
    if (lead) {
#pragma unroll
        for (int nt = 0; nt < 2; ++nt) { const f32x4 vn = f.uu[nt] - acc[nt];
            *(LAS v2u*)(VNt + (16 * nt + r16) * 144 + (16 * wm + 4 * q) * 2) = (v2u){pk2(vn.x, vn.y), pk2(vn.z, vn.w)}; }
    }
    __syncthreads();
    if (cs + 2 < 36) gdn_loadf(fn, gp + (size_t)(cs + 2) * GB_BYTES, lead, wave, wm, q, r16, s);
    bf16x8 vf[2][2];
#pragma unroll
    for (int nt = 0; nt < 2; ++nt)
#pragma unroll
        for (int ks = 0; ks < 2; ++ks) vf[nt][ks] = ldsfrag(VNt + (16 * nt + r16) * 144 + 64 * ks + 16 * q);
    if (!lead) {
#pragma unroll
        for (int nt = 0; nt < 2; ++nt) { acc[nt] = mfma16(f.fqk[0], vf[nt][0], acc[nt]); acc[nt] = mfma16(f.fqk[1], vf[nt][1], acc[nt]); }
#pragma unroll
        for (int rg = 0; rg < 4; ++rg) { const int row = scan_row(b, cs, 16 * wm + 4 * q + rg, d);
#pragma unroll
            for (int nt = 0; nt < 2; ++nt) O[(size_t)row * 768 + h * 128 + 32 * s + 16 * nt + r16] = acc[nt][rg]; }
    }
#pragma unroll
    for (int nt = 0; nt < 2; ++nt) { accS[nt] = accS[nt] * f.gt; accS[nt] = mfma16(f.fkd[0], vf[nt][0], accS[nt]); accS[nt] = mfma16(f.fkd[1], vf[nt][1], accS[nt]);
        *(LAS v2u*)(St + (16 * nt + r16) * 272 + (16 * wave + 4 * q) * 2) = (v2u){pk2(accS[nt].x, accS[nt].y), pk2(accS[nt].z, accS[nt].w)}; }
    __syncthreads();
}
__device__ __forceinline__ void gdn_scan_unit(const Args& a, LAS unsigned char* lds, int tid, int lane, int wave, int unit) {
    const int s = unit & 3, chain = unit >> 2, b = chain / 12, h = (chain >> 1) % 6, d = chain & 1;
    const unsigned char* gp = a.ws + WS_GDN + (size_t)chain * 36 * GB_BYTES;
    LAS unsigned char* St = lds;
    LAS unsigned char* VNt = lds + 8704;
    float* O = (float*)(a.ws + WS_OG) + (size_t)d * MA * 768;
    const int q = lane >> 4, r16 = lane & 15, wm = wave & 3; const bool lead = wave < 4;
    for (int i = tid; i < 8704 / 4; i += NWAVES * 64) ((LAS unsigned*)St)[i] = 0u;
    f32x4 accS[2] = {(f32x4){0.f, 0.f, 0.f, 0.f}, (f32x4){0.f, 0.f, 0.f, 0.f}};
    GdnFrag f0, f1, f2;
    gdn_loadf(f0, gp, lead, wave, wm, q, r16, s); gdn_loadf(f1, gp + GB_BYTES, lead, wave, wm, q, r16, s);
    __syncthreads();
#pragma unroll 1
    for (int cs = 0; cs < 36; cs += 3) {
        gdn_step(f0, f2, gp, cs, accS, St, VNt, O, lead, wave, wm, q, r16, s, b, h, d);
        gdn_step(f1, f0, gp, cs + 1, accS, St, VNt, O, lead, wave, wm, q, r16, s, b, h, d);
        gdn_step(f2, f1, gp, cs + 2, accS, St, VNt, O, lead, wave, wm, q, r16, s, b, h, d);
    }
}

__device__ __forceinline__ void mlstm_chunk_chain(const Args& a, LAS unsigned char* lds, int tid, int lane, int wave, int l, int chain) {
    const int b = chain / 12, h = (chain >> 1) % 6, d = chain & 1;
    LAS unsigned char* Qs = lds;
    LAS unsigned char* Ks = lds + 9216;
    LAS unsigned char* KwT = lds + 18432;
    LAS unsigned char* Sd = lds + 27648;
    LAS unsigned char* Vt = lds + 36864;
    LAS unsigned char* Ct = lds + 57600;
    LAS float* sc = (LAS float*)(lds + 78336);
    const bf16* P = (const bf16*)(a.ws + WS_PBUF); const float* Gt = (const float*)(a.ws + WS_GBUF);
    float* H = (float*)(a.ws + WS_HM) + (size_t)d * MA * 768;
    const float ib = a.in[I_IB][(l * 2 + d) * 6 + h], fb = a.in[I_FB][(l * 2 + d) * 6 + h];
    const int q = lane >> 4, r16 = lane & 15, wm = wave & 3, wg = wave >> 2;
    for (int i = tid; i < (57600 + 20736 - 36864) / 4; i += NWAVES * 64) ((LAS unsigned*)Vt)[i] = 0u;
    __syncthreads();
    for (int i = tid; i < 32; i += NWAVES * 64) ((LAS unsigned*)(Vt + 128 * 144))[i] = 0x3f803f80u;
    f32x4 accC[5];
#pragma unroll
    for (int k = 0; k < 5; ++k) accC[k] = (f32x4){0.f, 0.f, 0.f, 0.f};
    float m_st = 0.f;
    const int sj = tid >> 3, l8 = tid & 7;
    float graw_i = 0.f, graw_f = 0.f; int grow = 0; v4u rq8, rk8, rv0, rv1;
#define ML_ROW(cs_, pos_in_chunk, rowvar) do { const bool isc_ = (cs_) < 4; const int pos_ = ((isc_) ? (cs_) : (cs_) - 4) * 64 + (pos_in_chunk); \
        if (isc_) { const int t_ = d ? TC - 1 - pos_ : pos_; rowvar = ML + b * TC + t_; } else { const int p_ = d ? TL - 1 - pos_ : pos_; rowvar = b * TL + (p_ & 31) * 64 + (p_ >> 5); } } while (0)
#define ML_FETCH(cs_) do { if (wave == 0) { ML_ROW(cs_, lane, grow); graw_i = Gt[(size_t)grow * 128 + GC_I + d * 6 + h]; graw_f = Gt[(size_t)grow * 128 + GC_F + d * 6 + h]; } \
        int row_; ML_ROW(cs_, sj, row_); const bf16* pr_ = P + (size_t)row_ * LDP; \
        rq8 = *(const v4u*)(pr_ + PC_MQ + h * 64 + 8 * l8); rk8 = *(const v4u*)(pr_ + PC_MK + h * 64 + 8 * l8); \
        rv0 = *(const v4u*)(pr_ + PC_MV + h * 128 + 16 * l8); rv1 = *(const v4u*)(pr_ + PC_MV + h * 128 + 16 * l8 + 8); } while (0)
    ML_FETCH(0);
#pragma unroll 1
    for (int cs = 0; cs < 36; ++cs) {
        if (wave == 0) {
            const float ig = graw_i + ib; float bb = logsigmoidf(graw_f + fb);
#pragma unroll
            for (int o = 1; o < 64; o <<= 1) { const float t_ = __shfl_up(bb, o); if (lane >= o) bb += t_; }
            const float av = ig - bb; float cm = av;
#pragma unroll
            for (int o = 1; o < 64; o <<= 1) { const float t_ = __shfl_up(cm, o); if (lane >= o) cm = fmaxf(cm, t_); }
            sc[lane] = bb; sc[64 + lane] = av; sc[128 + lane] = cm; ((LAS int*)sc)[192 + lane] = grow;
        }
        __syncthreads();
        const float b63 = sc[63], cm63 = sc[128 + 63];
        const float m_chunk = b63 + cm63, m_new = fmaxf(b63 + m_st, m_chunk), a_old = __expf(b63 + m_st - m_new), a_new = __expf(m_chunk - m_new);
        {
            const int j = sj;
            const v4u q8 = rq8, k8 = rk8, v0 = rv0, v1 = rv1;
            v4u qo; qo.x = pk2(bflo(q8.x) * 0.125f, bfhi(q8.x) * 0.125f); qo.y = pk2(bflo(q8.y) * 0.125f, bfhi(q8.y) * 0.125f); qo.z = pk2(bflo(q8.z) * 0.125f, bfhi(q8.z) * 0.125f); qo.w = pk2(bflo(q8.w) * 0.125f, bfhi(q8.w) * 0.125f);
            *(LAS v4u*)(Qs + j * 144 + 16 * l8) = qo; *(LAS v4u*)(Ks + j * 144 + 16 * l8) = k8;
            const float wj = __expf(sc[64 + j] - cm63) * a_new;
            const unsigned kk[4] = {k8.x, k8.y, k8.z, k8.w};
#pragma unroll
            for (int e = 0; e < 4; ++e) { *(LAS unsigned short*)(KwT + (8 * l8 + 2 * e) * 144 + j * 2) = (unsigned short)f2bf(bflo(kk[e]) * wj); *(LAS unsigned short*)(KwT + (8 * l8 + 2 * e + 1) * 144 + j * 2) = (unsigned short)f2bf(bfhi(kk[e]) * wj); }
            const unsigned vv[8] = {v0.x, v0.y, v0.z, v0.w, v1.x, v1.y, v1.z, v1.w};
#pragma unroll
            for (int e = 0; e < 8; ++e) { *(LAS unsigned short*)(Vt + (16 * l8 + 2 * e) * 144 + j * 2) = (unsigned short)(vv[e] & 0xffffu); *(LAS unsigned short*)(Vt + (16 * l8 + 2 * e + 1) * 144 + j * 2) = (unsigned short)(vv[e] >> 16); }
        }
        if (cs + 1 < 36) ML_FETCH(cs + 1);
        __syncthreads();
        {
            const bf16x8 ka0 = ldsfrag(Ks + (16 * wm + r16) * 144 + 16 * q), ka1 = ldsfrag(Ks + (16 * wm + r16) * 144 + 64 + 16 * q);
#pragma unroll
            for (int t2 = 0; t2 < 2; ++t2) { const int it = 2 * wg + t2;
                f32x4 acc = (f32x4){0.f, 0.f, 0.f, 0.f};
                acc = mfma16(ka0, ldsfrag(Qs + (16 * it + r16) * 144 + 16 * q), acc); acc = mfma16(ka1, ldsfrag(Qs + (16 * it + r16) * 144 + 64 + 16 * q), acc);
                const int i = 16 * it + r16; const float cmi = sc[128 + i]; float sv[4];
#pragma unroll
                for (int rg = 0; rg < 4; ++rg) { const int j = 16 * wm + 4 * q + rg; sv[rg] = j <= i ? acc[rg] * __expf(sc[64 + j] - cmi) : 0.f; }
                *(LAS v2u*)(Sd + i * 144 + (16 * wm + 4 * q) * 2) = (v2u){pk2(sv[0], sv[1]), pk2(sv[2], sv[3])}; }
        }
        __syncthreads();
        {
            const bf16x8 sa0 = ldsfrag(Sd + (16 * wm + r16) * 144 + 16 * q), sa1 = ldsfrag(Sd + (16 * wm + r16) * 144 + 64 + 16 * q);
            const bf16x8 qa0 = ldsfrag(Qs + (16 * wm + r16) * 144 + 16 * q), qa1 = ldsfrag(Qs + (16 * wm + r16) * 144 + 64 + 16 * q);
            f32x4 nI = (f32x4){0.f, 0.f, 0.f, 0.f}, nC = (f32x4){0.f, 0.f, 0.f, 0.f};
            nI = mfma16(sa0, ldsfrag(Vt + (128 + r16) * 144 + 16 * q), nI); nI = mfma16(sa1, ldsfrag(Vt + (128 + r16) * 144 + 64 + 16 * q), nI);
            nC = mfma16(qa0, ldsfrag(Ct + (128 + r16) * 144 + 16 * q), nC); nC = mfma16(qa1, ldsfrag(Ct + (128 + r16) * 144 + 64 + 16 * q), nC);
            float fi[4], fc[4], rden[4]; int rows[4];
#pragma unroll
            for (int rg = 0; rg < 4; ++rg) { const int i = 16 * wm + 4 * q + rg;
                const float den_i = __shfl(nI[rg], lane & 48), qn_i = __shfl(nC[rg], lane & 48);
                const float bi = sc[i], mi = bi + sc[128 + i], mt_ = fmaxf(bi + m_st, mi);
                fc[rg] = __expf(bi + m_st - mt_); fi[rg] = __expf(mi - mt_);
                rden[rg] = 1.0f / fmaxf(fabsf(fc[rg] * qn_i + fi[rg] * den_i), __expf(-mt_)); rows[rg] = ((const LAS int*)sc)[192 + i]; }
#pragma unroll
            for (int t4 = 0; t4 < 4; ++t4) { const int et = 4 * wg + t4;
                f32x4 aI = (f32x4){0.f, 0.f, 0.f, 0.f}, aC = (f32x4){0.f, 0.f, 0.f, 0.f};
                aI = mfma16(sa0, ldsfrag(Vt + (16 * et + r16) * 144 + 16 * q), aI); aI = mfma16(sa1, ldsfrag(Vt + (16 * et + r16) * 144 + 64 + 16 * q), aI);
                aC = mfma16(qa0, ldsfrag(Ct + (16 * et + r16) * 144 + 16 * q), aC); aC = mfma16(qa1, ldsfrag(Ct + (16 * et + r16) * 144 + 64 + 16 * q), aC);
#pragma unroll
                for (int rg = 0; rg < 4; ++rg) H[(size_t)rows[rg] * 768 + h * 128 + 16 * et + r16] = (fc[rg] * aC[rg] + fi[rg] * aI[rg]) * rden[rg]; }
        }
        __syncthreads();
        {
            const bf16x8 kw0 = ldsfrag(KwT + (16 * wm + r16) * 144 + 16 * q), kw1 = ldsfrag(KwT + (16 * wm + r16) * 144 + 64 + 16 * q);
#pragma unroll
            for (int t5 = 0; t5 < 5; ++t5) { if (t5 < 4 || wg == 1) { const int et = 4 * wg + t5;
                accC[t5] = accC[t5] * a_old;
                accC[t5] = mfma16(kw0, ldsfrag(Vt + (16 * et + r16) * 144 + 16 * q), accC[t5]); accC[t5] = mfma16(kw1, ldsfrag(Vt + (16 * et + r16) * 144 + 64 + 16 * q), accC[t5]);
                *(LAS v2u*)(Ct + (16 * et + r16) * 144 + (16 * wm + 4 * q) * 2) = (v2u){pk2(accC[t5].x, accC[t5].y), pk2(accC[t5].z, accC[t5].w)}; } }
            m_st = m_new;
        }
        __syncthreads();
    }
#undef ML_ROW
#undef ML_FETCH
}

constexpr size_t ST_T1 = 0, ST_T3 = 262144, ST_KT = 524288, ST_A64 = 557568, ST_BYTES = 589824;
__device__ __forceinline__ void s5_tables_unit(const Args& a, LAS unsigned char* lds, int tid_in, int unit) {
    int tid = tid_in; asm volatile("" : "+v"(tid));
    const int dg = unit;
    unsigned char* tb = a.ws + WS_S5T + (size_t)dg * ST_BYTES;
    LAS float* PW = (LAS float*)lds;
    LAS float* BB = (LAS float*)(lds + 33280);
    LAS float* CC = (LAS float*)(lds + 41472);
    {
        const int p = tid & 63, part = tid >> 6;
        const float lre = a.in[I_LAMRE][dg * 64 + p], lim = a.in[I_LAMIM][dg * 64 + p], dt = expf(a.in[I_LOGDT][dg]);
        const float mag = expf(lre * dt), ang = lim * dt;
        const float abr = mag * cosf(ang), abi = mag * sinf(ang);
        float a8r = abr, a8i = abi;
#pragma unroll
        for (int s = 0; s < 3; ++s) { const float t = a8r * a8r - a8i * a8i; a8i = 2.f * a8r * a8i; a8r = t; }
        float cr_ = 1.f, ci_ = 0.f;
        for (int s = 0; s < part; ++s) { const float t = cr_ * a8r - ci_ * a8i; ci_ = cr_ * a8i + ci_ * a8r; cr_ = t; }
        for (int k = 8 * part; k < 8 * part + 8; ++k) { PW[(k * 64 + p) * 2] = cr_; PW[(k * 64 + p) * 2 + 1] = ci_; const float t = cr_ * abr - ci_ * abi; ci_ = cr_ * abi + ci_ * abr; cr_ = t; }
        if (part == 7) { PW[(64 * 64 + p) * 2] = cr_; PW[(64 * 64 + p) * 2 + 1] = ci_; ((float*)(tb + ST_A64))[2 * p] = cr_; ((float*)(tb + ST_A64))[2 * p + 1] = ci_; }
        if (part < 2) {
            const float den = lre * lre + lim * lim;
            const float f_re = ((abr - 1.f) * lre + abi * lim) / den, f_im = (abi * lre - (abr - 1.f) * lim) / den;
            for (int hh = 0; hh < 8; ++hh) { const int h = 8 * part + hh; const float br = a.in[I_BRE][(size_t)(dg * 64 + p) * 16 + h], bi = a.in[I_BIM][(size_t)(dg * 64 + p) * 16 + h];
                BB[(p * 16 + h) * 2] = f_re * br - f_im * bi; BB[(p * 16 + h) * 2 + 1] = f_re * bi + f_im * br; }
        } else if (part < 4) {
            for (int hh = 0; hh < 8; ++hh) { const int h = 8 * (part - 2) + hh; CC[(h * 64 + p) * 2] = a.in[I_CRE][(size_t)(dg * 16 + h) * 64 + p]; CC[(h * 64 + p) * 2 + 1] = a.in[I_CIM][(size_t)(dg * 16 + h) * 64 + p]; }
        }
    }
    __syncthreads();
#pragma unroll 1
    for (int it = tid; it < 4096; it += NWAVES * 64) {
        const int p = it >> 6, j = it & 63; const float pr = PW[((63 - j) * 64 + p) * 2], pi = PW[((63 - j) * 64 + p) * 2 + 1];
        unsigned wr[8], wi[8];
#pragma unroll
        for (int h2 = 0; h2 < 8; ++h2) { const f32x4 bb = *(const LAS f32x4*)(BB + (p * 16 + 2 * h2) * 2);
            wr[h2] = pk2(pr * bb.x - pi * bb.y, pr * bb.z - pi * bb.w); wi[h2] = pk2(pr * bb.y + pi * bb.x, pr * bb.w + pi * bb.z); }
        v4u* o0 = (v4u*)(tb + ST_T1 + ((size_t)p * 1024 + j * 16) * 2); v4u* o1 = (v4u*)(tb + ST_T1 + ((size_t)(64 + p) * 1024 + j * 16) * 2);
        o0[0] = (v4u){wr[0], wr[1], wr[2], wr[3]}; o0[1] = (v4u){wr[4], wr[5], wr[6], wr[7]}; o1[0] = (v4u){wi[0], wi[1], wi[2], wi[3]}; o1[1] = (v4u){wi[4], wi[5], wi[6], wi[7]};
    }
#pragma unroll 1
    for (int it = tid; it < 1024; it += NWAVES * 64) {
        const int t = it >> 4, h = it & 15;
        v4u* o0 = (v4u*)(tb + ST_T3 + (size_t)it * 256); v4u* o1 = (v4u*)(tb + ST_T3 + (size_t)it * 256 + 128);
#pragma unroll 1
        for (int p8 = 0; p8 < 8; ++p8) { float zr[8], zi[8];
#pragma unroll
            for (int e = 0; e < 8; ++e) { const int p = 8 * p8 + e; const float pr = PW[((t + 1) * 64 + p) * 2], pi = PW[((t + 1) * 64 + p) * 2 + 1], cr_ = CC[(h * 64 + p) * 2], ci_ = CC[(h * 64 + p) * 2 + 1];
                zr[e] = cr_ * pr - ci_ * pi; zi[e] = -(cr_ * pi + ci_ * pr); }
            o0[p8] = (v4u){pk2(zr[0], zr[1]), pk2(zr[2], zr[3]), pk2(zr[4], zr[5]), pk2(zr[6], zr[7])}; o1[p8] = (v4u){pk2(zi[0], zi[1]), pk2(zi[2], zi[3]), pk2(zi[4], zi[5]), pk2(zi[6], zi[7])}; }
    }
#pragma unroll 1
    for (int it = tid; it < 1024; it += NWAVES * 64) {
        const int lag = it >> 4, h = it & 15; float acc[16];
#pragma unroll
        for (int e = 0; e < 16; ++e) acc[e] = 0.f;
#pragma unroll 2
        for (int p = 0; p < 64; ++p) { const float pr = PW[(lag * 64 + p) * 2], pi = PW[(lag * 64 + p) * 2 + 1], cr_ = CC[(h * 64 + p) * 2], ci_ = CC[(h * 64 + p) * 2 + 1];
            const float zr = cr_ * pr - ci_ * pi, zi = cr_ * pi + ci_ * pr;
#pragma unroll
            for (int h2 = 0; h2 < 8; ++h2) { const f32x4 bb = *(const LAS f32x4*)(BB + (p * 16 + 2 * h2) * 2); acc[2 * h2] += zr * bb.x - zi * bb.y; acc[2 * h2 + 1] += zr * bb.z - zi * bb.w; } }
        v4u* o = (v4u*)(tb + ST_KT + ((size_t)(lag + 1) * 256 + h * 16) * 2);
        o[0] = (v4u){pk2(acc[0], acc[1]), pk2(acc[2], acc[3]), pk2(acc[4], acc[5]), pk2(acc[6], acc[7])}; o[1] = (v4u){pk2(acc[8], acc[9]), pk2(acc[10], acc[11]), pk2(acc[12], acc[13]), pk2(acc[14], acc[15])};
    }
    if (tid < 32) ((v4u*)(tb + ST_KT))[tid] = (v4u){0u, 0u, 0u, 0u};
    __syncthreads();
}

__device__ __forceinline__ void s5_mm_unit(const Args& a, LAS unsigned char* lds, int tid_in, int l, int unit) {
    int tid = tid_in; asm volatile("" : "+v"(tid));
    const int lane = tid & 63, wave = __builtin_amdgcn_readfirstlane(tid >> 6), q = lane >> 4, r16 = lane & 15;
    const int b = unit >> 6, g = (unit >> 1) & 31, d = unit & 1;
    const int dg = (l * 2 + d) * 32 + g;
    const unsigned char* tb = a.ws + WS_S5T + (size_t)dg * ST_BYTES;
    LAS unsigned char* Us = lds;
    LAS unsigned char* KT = lds + 74304;
    LAS float* E = (LAS float*)(lds + 107584);
    LAS unsigned char* SinT = lds + 132160;
    const bf16* P = (const bf16*)(a.ws + WS_PBUF);
    float* Y = (float*)(a.ws + WS_YS5) + (size_t)d * MA * 512;
#pragma unroll
    for (int it_ = 0; it_ < 5; ++it_) { const int idx = tid + it_ * NWAVES * 64; if (idx < 2304) { const int c = idx >> 6, j = idx & 63, row = scan_row(b, c, j, d);
        const v4u* up = (const v4u*)(P + (size_t)row * LDP + PC_U + g * 16); const v4u u0 = up[0], u1 = up[1];
        *(LAS v4u*)(Us + c * 2064 + j * 32) = u0; *(LAS v4u*)(Us + c * 2064 + j * 32 + 16) = u1; } }
#pragma unroll
    for (int it_ = 0; it_ < 5; ++it_) { const int i = tid + it_ * NWAVES * 64; if (i < 2080) *(LAS v4u*)(KT + i * 16) = *(const v4u*)(tb + ST_KT + (size_t)i * 16); }
    for (int i = tid; i < 13056 / 4; i += NWAVES * 64) ((LAS unsigned*)SinT)[i] = 0u;
    __syncthreads();
    int cc[3];
#pragma unroll
    for (int nt = 0; nt < 3; ++nt) { const int c = 16 * nt + r16; cc[nt] = (c < 36 ? c : 35) * 2064 + (q >> 1) * 32 + (q & 1) * 16; }
    {
        f32x4 acc[3] = {(f32x4){0.f, 0.f, 0.f, 0.f}, (f32x4){0.f, 0.f, 0.f, 0.f}, (f32x4){0.f, 0.f, 0.f, 0.f}};
        const unsigned char* ap = tb + ST_T1 + ((size_t)(16 * wave + r16) * 1024 + 8 * q) * 2;
#pragma unroll 16
        for (int ks = 0; ks < 32; ++ks) { const bf16x8 af = glbfrag(ap + ks * 64);
#pragma unroll
            for (int nt = 0; nt < 3; ++nt) acc[nt] = mfma16(af, ldsfrag(Us + cc[nt] + ks * 64), acc[nt]); }
#pragma unroll
        for (int nt = 0; nt < 3; ++nt)
#pragma unroll
            for (int rg = 0; rg < 4; ++rg) E[(16 * wave + 4 * q + rg) * 48 + 16 * nt + r16] = acc[nt][rg];
    }
    __syncthreads();
    if (wave == 0) {
        const int p = lane; const float a64r = ((const float*)(tb + ST_A64))[2 * p], a64i = ((const float*)(tb + ST_A64))[2 * p + 1];
        float cr_ = 0.f, ci_ = 0.f;
        for (int c = 0; c < 36; ++c) { *(LAS unsigned short*)(SinT + c * 272 + p * 2) = (unsigned short)f2bf(cr_); *(LAS unsigned short*)(SinT + c * 272 + (64 + p) * 2) = (unsigned short)f2bf(ci_);
            const float er = E[p * 48 + c], ei = E[(64 + p) * 48 + c];
            const float nr_ = a64r * cr_ - a64i * ci_ + er, ni_ = a64r * ci_ + a64i * cr_ + ei; cr_ = nr_; ci_ = ni_; }
    }
    __syncthreads();
    {
        f32x4 acc[8][3];
#pragma unroll
        for (int m = 0; m < 8; ++m)
#pragma unroll
            for (int nt = 0; nt < 3; ++nt) acc[m][nt] = (f32x4){0.f, 0.f, 0.f, 0.f};
#pragma unroll 2
        for (int k4 = 0; k4 < 4; ++k4) {
            bf16x8 bf[3];
#pragma unroll
            for (int nt = 0; nt < 3; ++nt) bf[nt] = ldsfrag(SinT + (16 * nt + r16) * 272 + k4 * 64 + 16 * q);
#pragma unroll
            for (int m = 0; m < 8; ++m) { const bf16x8 af = glbfrag(tb + ST_T3 + ((size_t)((wave + 8 * m) * 16 + r16) * 128 + k4 * 32 + 8 * q) * 2);
#pragma unroll
                for (int nt = 0; nt < 3; ++nt) acc[m][nt] = mfma16(af, bf[nt], acc[m][nt]); }
        }
        const int kto = (r16 * 16 + 8 * (q & 1)) * 2 - (q >> 1) * 512 + 512;
#pragma unroll 1
        for (int ks = 0; ks < 32; ++ks) {
            bf16x8 bf[3];
#pragma unroll
            for (int nt = 0; nt < 3; ++nt) bf[nt] = ldsfrag(Us + cc[nt] + ks * 64);
#pragma unroll
            for (int m = 0; m < 8; ++m) { const int t = wave + 8 * m;
                if (t >= 2 * ks) { const bf16x8 af = ldsfrag(KT + kto + (t - 2 * ks) * 512);
#pragma unroll
                    for (int nt = 0; nt < 3; ++nt) acc[m][nt] = mfma16(af, bf[nt], acc[m][nt]); } }
        }
#pragma unroll
        for (int nt = 0; nt < 3; ++nt) { const int c = 16 * nt + r16;
            if (c < 36) {
#pragma unroll
                for (int m = 0; m < 8; ++m) { const int row = scan_row(b, c, wave + 8 * m, d); *(f32x4*)(Y + (size_t)row * 512 + g * 16 + 4 * q) = acc[m][nt]; } } }
    }
    __syncthreads();
}

constexpr int N_PHASES = 22; constexpr int S5_M1 = 256;
__global__ void __launch_bounds__(NWAVES * 64, 2) fwd_kernel(Args args) {
    extern __shared__ __attribute__((aligned(16))) unsigned char lds_raw[];
    LAS unsigned char* lds = (LAS unsigned char*)lds_raw;
    const int G = gridDim.x, bid = blockIdx.x, NGW = G * NWAVES;
    for (int u = threadIdx.x; u < (LDS_BYTES - LDSCTL_OFF) / 4; u += NWAVES * 64) ((LAS unsigned*)(lds + LDSCTL_OFF))[u] = 0u;
    __syncthreads();
    volatile LAS unsigned* MISC = (volatile LAS unsigned*)(lds + MISC_OFF);
    XcdBarrier bar; bar.bar = (unsigned*)(args.ws + WS_CTL) + CW_BAR; bar.x = 0; bar.st = nullptr;
#if !MK_PER_PHASE
    bar = xcd_barrier_post((unsigned*)(args.ws + WS_CTL) + CW_BAR, MISC + 8);
#endif
    const int lo = args.ph_lo, hi = args.ph_hi;
#define IN(k) (lo <= (k) && (k) < hi)
#define PH_IDS() int tid = threadIdx.x; asm volatile("" : "+v"(tid)); const int lane = tid & 63, wave = __builtin_amdgcn_readfirstlane(tid >> 6), gw = bid * NWAVES + wave; (void)lane; (void)gw
#define SEAM(k) do { if (IN(k) && IN((k) + 1)) xcd_barrier(bar); } while (0)

    if (IN(0)) { PH_IDS(); p0_prologue(args, lds, tid, lane, wave, bid, G); }
    SEAM(0);
    if (IN(1)) { PH_IDS(); rowpass<true, false, false, false, true>(args, gw, NGW, lane, MA, 0, 0, nullptr, 0, args.in[I_NMPRE], 0, 1); }
    SEAM(1);
#pragma unroll 1
    for (int l = 0; l < DEPTH; ++l) {
        const int pb = 2 + 10 * l;
        unsigned char* wl = args.ws + WS_W + (size_t)l * W_LAYER;
        const int Mrows = (l == DEPTH - 1) ? ML : MA;
        if (IN(pb + 0)) {
            pg8::Gemm g{(const pg8::bf16_t*)(args.ws + WS_ABUF), (const pg8::bf16_t*)wl, MA, N1, D}; pg8::StaticOrder S; S.init(MA, N1, G, bid);
            pg8::EpiProj E{(pg8::bf16_t*)(args.ws + WS_PBUF), LDP, (float*)(args.ws + WS_GBUF), GATE_TILE};
            pg8::gemm_phase<pg8::EpiProj, pg8::StaticOrder, true, true>(lds, g, S, E);
        }
        SEAM(pb + 0);
        if (IN(pb + 1)) {
            PH_IDS();
            if (bid < 48) mlstm_chunk_chain(args, lds, tid, lane, wave, l, bid);
            else { for (int u = bid - 48; u < S5_M1 + 864; u += G - 48) { if (u < S5_M1) s5_mm_unit(args, lds, tid, l, u); else gdn_prep_unit(args, lds, tid, l, u - S5_M1); } }
        }
        SEAM(pb + 1);
        if (IN(pb + 2)) {
            PH_IDS();
            if (bid < 192) gdn_scan_unit(args, lds, tid, lane, wave, bid);

        }
        SEAM(pb + 2);
        if (IN(pb + 3)) { PH_IDS(); finalize_rows(args, gw, NGW, lane, Mrows, l); }
        SEAM(pb + 3);
        if (IN(pb + 4)) {
            pg8::Gemm g{(const pg8::bf16_t*)(args.ws + WS_Y5), (const pg8::bf16_t*)(wl + WGLU_OFF), Mrows, 512, 512}; pg8::StaticOrder S; S.init(Mrows, 512, G, bid);
            pg8::EpiGlu E{(const pg8::bf16_t*)(args.ws + WS_Y5), 512, (pg8::bf16_t*)(args.ws + WS_MIX), D, args.in[I_GLUB] + l * 512};
            pg8::gemm_phase<pg8::EpiGlu, pg8::StaticOrder, true, true>(lds, g, S, E);
        }
        SEAM(pb + 4);
        if (IN(pb + 5)) {
            pg8::Gemm g{(const pg8::bf16_t*)(args.ws + WS_MIX), (const pg8::bf16_t*)(wl + WO_OFF), Mrows, D, D}; pg8::StaticOrder S; S.init(Mrows, D, G, bid);
            pg8::EpiF32 E{(float*)(args.ws + WS_R), D};
            pg8::gemm_phase<pg8::EpiF32, pg8::StaticOrder, true, true>(lds, g, S, E);
        }
        SEAM(pb + 5);
        if (IN(pb + 6)) {
            PH_IDS();
            if (l == 0) rowpass<true, true, true, false, true>(args, gw, NGW, lane, Mrows, l, 2, args.in[I_NMPOST] + l * D, l, args.in[I_NFPRE] + l * D, 3, 4);
            else rowpass<false, true, true, false, true>(args, gw, NGW, lane, Mrows, l, 2, args.in[I_NMPOST] + l * D, l, args.in[I_NFPRE] + l * D, 3, 4);
        }
        SEAM(pb + 6);
        if (IN(pb + 7)) {
            pg8::Gemm g{(const pg8::bf16_t*)(args.ws + WS_ABUF), (const pg8::bf16_t*)(wl + WGU_OFF), Mrows, 2 * FF, D}; pg8::StaticOrder S; S.init(Mrows, 2 * FF, G, bid);
            pg8::EpiSwiGLU E{(pg8::bf16_t*)(args.ws + WS_PBUF), FF};
            pg8::gemm_phase<pg8::EpiSwiGLU, pg8::StaticOrder, true, true>(lds, g, S, E);
        }
        SEAM(pb + 7);
        if (IN(pb + 8)) {
            pg8::Gemm g{(const pg8::bf16_t*)(args.ws + WS_PBUF), (const pg8::bf16_t*)(wl + WD_OFF), Mrows, D, FF}; pg8::StaticOrder S; S.init(Mrows, D, G, bid);
            pg8::EpiF32 E{(float*)(args.ws + WS_R), D};
            pg8::gemm_phase<pg8::EpiF32, pg8::StaticOrder, true, true>(lds, g, S, E);
        }
        SEAM(pb + 8);
        if (IN(pb + 9)) {
            PH_IDS();
            if (l < DEPTH - 1) rowpass<false, true, true, false, true>(args, gw, NGW, lane, Mrows, l, 5, args.in[I_NFPOST] + l * D, l + 1, args.in[I_NMPRE] + (l + 1) * D, 0, 1);
            else rowpass<false, true, false, true, false>(args, gw, NGW, lane, Mrows, l, 5, args.in[I_NFPOST] + l * D, 0, nullptr, 0, 0);
        }
        SEAM(pb + 9);
    }
#undef IN
#undef SEAM
}

extern "C" void kernel_launch(void* const* d_in, const int* in_sizes, int n_in, void* d_out, int out_size, void* d_ws, size_t ws_size, hipStream_t stream) {
    static int grid = 0;
    if (grid == 0) {
        if (n_in != N_IN || in_sizes[0] != ML * D || out_size != ML * D || ws_size < WS_TOTAL) {
            fprintf(stderr, "kernel_launch: unexpected shapes (n_in %d, in0 %d, out %d, ws %zu, need %zu); nothing launched\n", n_in, n_in > 0 ? in_sizes[0] : -1, out_size, ws_size, (size_t)WS_TOTAL); grid = -1; return; }
        int dev = 0, cus = 0;
        if (hipGetDevice(&dev) != hipSuccess || hipDeviceGetAttribute(&cus, hipDeviceAttributeMultiprocessorCount, dev) != hipSuccess) { grid = -1; return; }
        if (hipFuncSetAttribute((const void*)fwd_kernel, hipFuncAttributeMaxDynamicSharedMemorySize, LDS_BYTES) != hipSuccess) { fprintf(stderr, "kernel_launch: hipFuncSetAttribute failed\n"); grid = -1; return; }
        int per_cu = 0;
        if (hipOccupancyMaxActiveBlocksPerMultiprocessor(&per_cu, (const void*)fwd_kernel, NWAVES * 64, LDS_BYTES) != hipSuccess || per_cu < 1)
            fprintf(stderr, "kernel_launch: occupancy query reports %d workgroups per CU\n", per_cu);
        (void)hipGetLastError();
        grid = cus;
        if (grid != 256) fprintf(stderr, "kernel_launch: %d CUs (built for 256)\n", grid);
    }
    if (grid < 0) return;
    (void)hipMemsetAsync((char*)d_ws + WS_CTL, 0, CTL_ZERO_BYTES, stream);
    Args a{};
    for (int i = 0; i < N_IN; ++i) a.in[i] = (const float*)d_in[i];
    a.out = (float*)d_out; a.ws = (unsigned char*)d_ws;
#if MK_PER_PHASE
    for (int ph = 0; ph < N_PHASES; ++ph) { a.ph_lo = ph; a.ph_hi = ph + 1; a.li = ph; hipLaunchKernelGGL(fwd_kernel, dim3(grid), dim3(NWAVES * 64), LDS_BYTES, stream, a); }
#else
    a.ph_lo = 0; a.ph_hi = N_PHASES; a.li = 0;
    hipLaunchKernelGGL(fwd_kernel, dim3(grid), dim3(NWAVES * 64), LDS_BYTES, stream, a);
#endif
}
```
